# Optimizing an MI355X kernel written in HIP

```python
import jax, jax.numpy as jnp
from jax import lax
import numpy as np

D_MODEL = 1024
BATCH = 16
SEQ = 2048
DEPTH = 2

GRID_W = 64
CTX_LEN = 256
HEAD_DIM = 64
A_Q_HEADS = 4
A_KV_HEADS = 2
B_Q_HEADS = 4
B_KV_HEADS = 2
WINDOW = 128
Q_BLOCK = 128
LRU_WIDTH = 512
LRU_BLOCKS = 8
CONV_W = 4
CONV_LEFT = CONV_W // 2
LRU_C = 8.0
D_FF = 4 * D_MODEL
ROPE_BASE = 10000.0
EPS = 1e-6
NEG_INF = -1e30

A_Q = A_Q_HEADS * HEAD_DIM
A_KV = A_KV_HEADS * HEAD_DIM
B_Q = B_Q_HEADS * HEAD_DIM
B_KV = B_KV_HEADS * HEAD_DIM
IN_WIDTHS = (A_Q, A_KV, A_KV, B_Q, B_KV, B_KV, LRU_WIDTH, LRU_WIDTH)
IN_WIDTH = sum(IN_WIDTHS)
MIX_WIDTH = A_Q + B_Q + LRU_WIDTH

kernel_name = 'hybrid_headgroup_diffusion_block'


def rms_norm(x, g):
    xf = x.astype(jnp.float32)
    y = xf * lax.rsqrt(jnp.mean(xf * xf, axis=-1, keepdims=True) + EPS)
    return (y * g.astype(jnp.float32)).astype(x.dtype)


def modulate(h, shift, scale):
    return h * (1 + scale) + shift


def axial_rope_tables(n):
    rows = n // GRID_W
    row = jnp.repeat(jnp.arange(rows, dtype=jnp.float32), GRID_W)
    col = jnp.tile(jnp.arange(GRID_W, dtype=jnp.float32), rows)
    half = HEAD_DIM // 2
    inv_freq = ROPE_BASE ** (-jnp.arange(0, half, 2, dtype=jnp.float32) / half)
    ang_r = row[:, None] * inv_freq
    ang_c = col[:, None] * inv_freq
    return jnp.cos(ang_r), jnp.sin(ang_r), jnp.cos(ang_c), jnp.sin(ang_c)


def rope_1d(x, cos, sin):
    h = x.shape[-1] // 2
    x1, x2 = x[..., :h], x[..., h:]
    cos, sin = cos[:, None, :], sin[:, None, :]
    return jnp.concatenate([x1 * cos - x2 * sin, x2 * cos + x1 * sin], axis=-1)


def apply_axial_rope(x, tabs):
    cos_r, sin_r, cos_c, sin_c = tabs
    xf = x.astype(jnp.float32)
    half = HEAD_DIM // 2
    out = jnp.concatenate([rope_1d(xf[..., :half], cos_r, sin_r),
                           rope_1d(xf[..., half:], cos_c, sin_c)], axis=-1)
    return out.astype(x.dtype)


def group_heads(q, n_kv):
    b, n, h, d = q.shape
    return q.reshape(b, n, n_kv, h // n_kv, d)


def sink_softmax(s, sink):
    m = jnp.maximum(jnp.max(s, axis=-1, keepdims=True), sink)
    p = jnp.exp(s - m)
    return p / (jnp.sum(p, axis=-1, keepdims=True) + jnp.exp(sink - m))


def attn_probs(s, sink):
    if sink is None:
        return jax.nn.softmax(s, axis=-1)
    return sink_softmax(s, sink)


def dense_attention(q, k, v, sink=None):
    s = jnp.einsum('bqkgd,bskd->bkgqs', q, k).astype(jnp.float32) * HEAD_DIM ** -0.5
    p = attn_probs(s, sink).astype(v.dtype)
    return jnp.einsum('bkgqs,bskd->bqkgd', p, v)


def global_block_attention(q, k, v):
    b, n, h, d = q.shape
    n_kv = k.shape[2]
    nb = n // Q_BLOCK
    qb = group_heads(q, n_kv).reshape(b, nb, Q_BLOCK, n_kv, h // n_kv, d)
    out = lax.map(lambda blk: dense_attention(blk, k, v), jnp.moveaxis(qb, 1, 0))
    return jnp.moveaxis(out, 0, 1).reshape(b, n, h * d)


def window_sink_attention(q, k, v, k_ctx, v_ctx, sink):
    b, n, h, d = q.shape
    n_kv = k.shape[2]
    nb = n // Q_BLOCK
    band = 3 * Q_BLOCK
    qb = group_heads(q, n_kv).reshape(b, nb, Q_BLOCK, n_kv, h // n_kv, d)

    def banded(t):
        tp = jnp.pad(t, ((0, 0), (WINDOW, WINDOW), (0, 0), (0, 0))).reshape(b, nb + 2, Q_BLOCK, n_kv, d)
        return jnp.concatenate([tp[:, :-2], tp[:, 1:-1], tp[:, 2:]], axis=2)

    kb, vb = banded(k), banded(v)
    start = jnp.arange(nb)[:, None, None] * Q_BLOCK
    qpos = start + jnp.arange(Q_BLOCK)[None, :, None]
    kpos = start - WINDOW + jnp.arange(band)[None, None, :]
    valid = (jnp.abs(qpos - kpos) <= WINDOW) & (kpos >= 0) & (kpos < n)
    scale = HEAD_DIM ** -0.5
    s_band = jnp.einsum('bnqkgd,bnskd->bnkgqs', qb, kb).astype(jnp.float32) * scale
    s_band = jnp.where(valid[None, :, None, None], s_band, NEG_INF)
    s_ctx = jnp.einsum('bnqkgd,bskd->bnkgqs', qb, k_ctx).astype(jnp.float32) * scale
    p = sink_softmax(jnp.concatenate([s_band, s_ctx], axis=-1), sink).astype(v.dtype)
    out = (jnp.einsum('bnkgqs,bnskd->bnqkgd', p[..., :band], vb)
           + jnp.einsum('bnkgqs,bskd->bnqkgd', p[..., band:], v_ctx))
    return out.reshape(b, n, h * d)


def centred_dwconv(x, w, bias):
    n = x.shape[1]
    xp = jnp.pad(x, ((0, 0), (CONV_LEFT, CONV_W - 1 - CONV_LEFT), (0, 0)))
    out = bias
    for j in range(CONV_W):
        out = out + xp[:, j:j + n] * w[j]
    return out


def rglru_coeffs(x, w_a, b_a, w_i, b_i, lam):
    b, n, width = x.shape
    xb = x.reshape(b, n, LRU_BLOCKS, width // LRU_BLOCKS)
    r = jax.nn.sigmoid(jnp.einsum('bnhi,hij->bnhj', xb, w_a).reshape(b, n, width) + b_a)
    i = jax.nn.sigmoid(jnp.einsum('bnhi,hij->bnhj', xb, w_i).reshape(b, n, width) + b_i)
    log_a = -LRU_C * r.astype(jnp.float32) * jax.nn.softplus(-lam.astype(jnp.float32))
    u = jnp.sqrt(-jnp.expm1(2.0 * log_a)) * (i * x).astype(jnp.float32)
    return jnp.exp(log_a), u


def _lin_combine(left, right):
    a1, b1 = left
    a2, b2 = right
    return a1 * a2, a2 * b1 + b2


def linear_scan(a, u, h0):
    a_cum, h_zero = lax.associative_scan(_lin_combine, (a, u), axis=1)
    return a_cum * h0[:, None, :] + h_zero


def directional_rglru(x_lat, x_ctx, w_a, b_a, w_i, b_i, lam):
    a_c, u_c = rglru_coeffs(x_ctx, w_a, b_a, w_i, b_i, lam)
    h_ctx = linear_scan(a_c, u_c, jnp.zeros((x_ctx.shape[0], x_ctx.shape[2]), jnp.float32))
    a_l, u_l = rglru_coeffs(x_lat, w_a, b_a, w_i, b_i, lam)
    h_lat = linear_scan(a_l, u_l, h_ctx[:, -1])
    return h_lat, h_ctx


def split_columns(t):
    parts, start = [], 0
    for w in IN_WIDTHS:
        parts.append(t[..., start:start + w])
        start += w
    return parts


def token_mixers(z, z_ctx, g_q_a, g_k_a, sink_b, conv_w, conv_b, lru_w_a, lru_b_a, lru_w_i, lru_b_i,
                 lru_lambda, rope, with_ctx_out):
    b, n, _ = z.shape
    m = z_ctx.shape[1]
    qa, ka, va, qb, kb, vb, xr, gr = split_columns(z)
    qa_c, ka_c, va_c, qb_c, kb_c, vb_c, xr_c, gr_c = split_columns(z_ctx)

    def heads(t):
        return t.reshape(t.shape[0], t.shape[1], -1, HEAD_DIM)

    qa = apply_axial_rope(rms_norm(heads(qa), g_q_a), rope)
    ka = apply_axial_rope(rms_norm(heads(ka), g_k_a), rope)
    qa_c = rms_norm(heads(qa_c), g_q_a)
    ka_c = rms_norm(heads(ka_c), g_k_a)
    va, va_c = heads(va), heads(va_c)
    out_a = global_block_attention(qa, jnp.concatenate([ka_c, ka], axis=1),
                                   jnp.concatenate([va_c, va], axis=1))

    qb = apply_axial_rope(heads(qb), rope)
    kb = apply_axial_rope(heads(kb), rope)
    vb, kb_c, vb_c = heads(vb), heads(kb_c), heads(vb_c)
    sink = sink_b.astype(jnp.float32).reshape(B_KV_HEADS, B_Q_HEADS // B_KV_HEADS, 1, 1)
    out_b = window_sink_attention(qb, kb, vb, kb_c, vb_c, sink)

    xr = centred_dwconv(xr, conv_w, conv_b)
    xr_c = centred_dwconv(xr_c, conv_w, conv_b)
    h_f, hc_f = directional_rglru(xr, xr_c, lru_w_a[0], lru_b_a[0], lru_w_i[0], lru_b_i[0], lru_lambda[0])
    h_b, hc_b = directional_rglru(jnp.flip(xr, axis=1), jnp.flip(xr_c, axis=1), lru_w_a[1], lru_b_a[1],
                                  lru_w_i[1], lru_b_i[1], lru_lambda[1])
    out_c = (h_f + jnp.flip(h_b, axis=1)).astype(z.dtype) * jax.nn.gelu(gr)

    feat = jnp.concatenate([out_a, out_b, out_c], axis=-1)
    if not with_ctx_out:
        return feat, None
    out_ac = dense_attention(group_heads(qa_c, A_KV_HEADS), ka_c, va_c).reshape(b, m, A_Q)
    out_bc = dense_attention(group_heads(heads(qb_c), B_KV_HEADS), kb_c, vb_c, sink).reshape(b, m, B_Q)
    out_cc = (hc_f + jnp.flip(hc_b, axis=1)).astype(z.dtype) * jax.nn.gelu(gr_c)
    return feat, jnp.concatenate([out_ac, out_bc, out_cc], axis=-1)


def sq_relu_mlp(h, w1, w2):
    return jnp.square(jax.nn.relu(h @ w1)) @ w2


def hybrid_layer(x, ctx, c_act, c_ctx_act, w_mod, b_mod, g_pre_mix, g_post_mix, g_pre_mlp, g_post_mlp,
                 w_in, g_q_a, g_k_a, sink_b, conv_w, conv_b, lru_w_a, lru_b_a, lru_w_i, lru_b_i, lru_lambda,
                 w_out, w_mlp_in, w_mlp_out, rope, update_ctx):
    sh1, sc1, gt1, sh2, sc2, gt2 = jnp.split((c_act @ w_mod + b_mod)[:, None, :], 6, axis=-1)
    csh1, csc1, cgt1, csh2, csc2, cgt2 = jnp.split(c_ctx_act @ w_mod + b_mod, 6, axis=-1)
    h = modulate(rms_norm(x, g_pre_mix), sh1, sc1)
    h_ctx = modulate(rms_norm(ctx, g_pre_mix), csh1, csc1)
    feat, feat_ctx = token_mixers(h @ w_in, h_ctx @ w_in, g_q_a, g_k_a, sink_b, conv_w, conv_b,
                                  lru_w_a, lru_b_a, lru_w_i, lru_b_i, lru_lambda, rope, update_ctx)
    x = x + gt1 * rms_norm(feat @ w_out, g_post_mix)
    h2 = modulate(rms_norm(x, g_pre_mlp), sh2, sc2)
    x = x + gt2 * rms_norm(sq_relu_mlp(h2, w_mlp_in, w_mlp_out), g_post_mlp)
    if update_ctx:
        ctx = ctx + cgt1 * rms_norm(feat_ctx @ w_out, g_post_mix)
        h2c = modulate(rms_norm(ctx, g_pre_mlp), csh2, csc2)
        ctx = ctx + cgt2 * rms_norm(sq_relu_mlp(h2c, w_mlp_in, w_mlp_out), g_post_mlp)
    return x, ctx


def setup_inputs(seed: int = 0) -> dict:
    key = jax.random.key(seed)
    ks = jax.random.split(key, 24)

    def nrm(k, shape, scale):
        return jax.random.normal(k, shape, jnp.float32) * scale

    def gain(k, shape):
        return 1.0 + 0.05 * jax.random.normal(k, shape, jnp.float32)

    hb = LRU_WIDTH // LRU_BLOCKS
    s = jax.random.uniform(ks[19], (DEPTH, 2, LRU_WIDTH), jnp.float32, 0.9, 0.999) ** (1.0 / LRU_C)
    return {
        'x': nrm(ks[0], (BATCH, SEQ, D_MODEL), 1.0),
        'c': nrm(ks[1], (BATCH, D_MODEL), 1.0),
        'ctx': nrm(ks[2], (BATCH, CTX_LEN, D_MODEL), 1.0),
        'c_ctx': nrm(ks[3], (D_MODEL,), 1.0),
        'w_mod': nrm(ks[4], (DEPTH, D_MODEL, 6 * D_MODEL), 0.5 * D_MODEL ** -0.5),
        'b_mod': nrm(ks[5], (DEPTH, 6 * D_MODEL), 0.01),
        'g_pre_mix': gain(ks[6], (DEPTH, D_MODEL)),
        'g_post_mix': gain(ks[7], (DEPTH, D_MODEL)),
        'g_pre_mlp': gain(ks[8], (DEPTH, D_MODEL)),
        'g_post_mlp': gain(ks[9], (DEPTH, D_MODEL)),
        'w_in': nrm(ks[10], (DEPTH, D_MODEL, IN_WIDTH), D_MODEL ** -0.5),
        'g_q_a': gain(ks[11], (DEPTH, HEAD_DIM)),
        'g_k_a': gain(ks[12], (DEPTH, HEAD_DIM)),
        'sink_b': nrm(ks[13], (DEPTH, B_Q_HEADS), 0.5),
        'conv_w': nrm(ks[14], (DEPTH, CONV_W, LRU_WIDTH), CONV_W ** -0.5),
        'conv_b': nrm(ks[15], (DEPTH, LRU_WIDTH), 0.01),
        'lru_w_a': nrm(ks[16], (DEPTH, 2, LRU_BLOCKS, hb, hb), hb ** -0.5),
        'lru_b_a': nrm(ks[17], (DEPTH, 2, LRU_WIDTH), 0.01),
        'lru_w_i': nrm(ks[18], (DEPTH, 2, LRU_BLOCKS, hb, hb), hb ** -0.5),
        'lru_b_i': nrm(ks[20], (DEPTH, 2, LRU_WIDTH), 0.01),
        'lru_lambda': jnp.log(s) - jnp.log1p(-s),
        'w_out': nrm(ks[21], (DEPTH, MIX_WIDTH, D_MODEL), MIX_WIDTH ** -0.5),
        'w_mlp_in': nrm(ks[22], (DEPTH, D_MODEL, D_FF), D_MODEL ** -0.5),
        'w_mlp_out': nrm(ks[23], (DEPTH, D_FF, D_MODEL), D_FF ** -0.5),
    }


def reference(x, c, ctx, c_ctx, w_mod, b_mod, g_pre_mix, g_post_mix, g_pre_mlp, g_post_mlp, w_in,
              g_q_a, g_k_a, sink_b, conv_w, conv_b, lru_w_a, lru_b_a, lru_w_i, lru_b_i, lru_lambda,
              w_out, w_mlp_in, w_mlp_out):
    rope = axial_rope_tables(x.shape[1])
    c_act = jax.nn.silu(c)
    c_ctx_act = jax.nn.silu(c_ctx)
    for l in range(DEPTH):
        x, ctx = hybrid_layer(x, ctx, c_act, c_ctx_act, w_mod[l], b_mod[l], g_pre_mix[l], g_post_mix[l],
                              g_pre_mlp[l], g_post_mlp[l], w_in[l], g_q_a[l], g_k_a[l], sink_b[l],
                              conv_w[l], conv_b[l], lru_w_a[l], lru_b_a[l], lru_w_i[l], lru_b_i[l],
                              lru_lambda[l], w_out[l], w_mlp_in[l], w_mlp_out[l], rope,
                              l < DEPTH - 1)
    return x
```

```cpp
#include <hip/hip_runtime.h>
#include <hip/hip_cooperative_groups.h>
#include <cstdio>
#include <cstdint>
namespace cg = cooperative_groups;
#ifndef MK_MULTI
#define MK_MULTI 0
#endif
namespace pg8 {
#define PG8_LAS __attribute__((address_space(3)))
typedef unsigned short bf16_t;
typedef short bf16x8 __attribute__((ext_vector_type(8)));
typedef float f32x4 __attribute__((ext_vector_type(4)));
typedef unsigned u32x4 __attribute__((ext_vector_type(4)));
constexpr int BM = 256, BK = 64, HALF = 128, HTB = HALF * BK * 2  , STAGE_BYTES = 8 * HTB, NXCD = 8, WGM = 8;

__host__ __device__ __forceinline__ int lds_byte(int r, int c) { const int st = (r >> 4) * 2 + (c >> 5), rr = r & 15, cc = c & 31, ob = rr * 64 + cc * 2; return st * 1024 + (ob ^ (((ob >> 9) & 1) << 5)); }
__host__ __device__ __forceinline__ void stage_rc(int b, int& R, int& C) { const int st = b / 1024, sb = b % 1024, swz = sb ^ (((sb >> 9) & 1) << 5); R = (st >> 1) * 16 + swz / 64; C = (st & 1) * 32 + (swz % 64) / 2; }
__host__ __device__ __forceinline__ int perm32(int rho) { const int n = rho >> 4, i = rho & 15; return 8 * (i >> 2) + 4 * n + (i & 3); }

struct Unit { int pm, pn; };
struct Gemm { const bf16_t* A; const bf16_t* Bt; int M, N, K; };

struct StaticOrder {
    int nM, nN, nwg, G, c;
    __host__ __device__ void init(int M, int N, int G_, int c_) { nM = M / BM; nN = N / BM; nwg = nM * nN; G = G_; c = c_; }
    __host__ __device__ bool next(int i, Unit& u) const {
        const long L = (long)i * G + c; if (L >= nwg) return false;
        int wgid = (int)L; { const int q = nwg / NXCD, r = nwg % NXCD, xcd = wgid % NXCD, off = wgid / NXCD; wgid = (xcd < r ? xcd * (q + 1) : r * (q + 1) + (xcd - r) * q) + off; }
        const int nig = WGM * nN, gid = wgid / nig, fm = gid * WGM, gsz = (nM - fm) < WGM ? (nM - fm) : WGM;
        u.pm = fm + ((wgid % nig) % gsz); u.pn = (wgid % nig) / gsz; return true;
    }
    __device__ __forceinline__ void a_ready(const Unit&) const {}
    __device__ __forceinline__ void done(const Unit&) const {}
};

__device__ __forceinline__ unsigned cvt_pk_bf16(float lo, float hi) { unsigned r; asm("v_cvt_pk_bf16_f32 %0, %1, %2" : "=v"(r) : "v"(lo), "v"(hi)); return r; }
template <int ACT> struct EpiStore {
    static constexpr bool PERM = true, AFTER_DRAIN = false;
    bf16_t* O; int ldc;
    __device__ __forceinline__ void operator()(const f32x4 (&acc)[2][2][4][2], const Unit& u, int wr, int wc, int fr, int fq) const {
        const int row0 = u.pm * BM + wr * 64 + fr; const int col0 = u.pn * BM + wc * 32 + 8 * fq;
#pragma unroll
        for (int ai = 0; ai < 2; ++ai)
#pragma unroll
            for (int m = 0; m < 4; ++m) { bf16_t* rowp = O + (size_t)(row0 + ai * HALF + m * 16) * ldc + col0;
#pragma unroll
                for (int bj = 0; bj < 2; ++bj) { f32x4 v0 = acc[ai][bj][m][0], v1 = acc[ai][bj][m][1];
                    if (ACT == 2) {
#pragma unroll
                        for (int j = 0; j < 4; ++j) { float a = v0[j] > 0.f ? v0[j] : 0.f; v0[j] = a * a; float b = v1[j] > 0.f ? v1[j] : 0.f; v1[j] = b * b; } }
                    u32x4 w; w.x = cvt_pk_bf16(v0[0], v0[1]); w.y = cvt_pk_bf16(v0[2], v0[3]); w.z = cvt_pk_bf16(v1[0], v1[1]); w.w = cvt_pk_bf16(v1[2], v1[3]);
                    *(u32x4*)(rowp + bj * HALF) = w; } }
    }
    __device__ __forceinline__ void fused(f32x4 (&)[2][2][4][2], const Unit&, int, int, int, int, PG8_LAS unsigned char*, int, int) const {}
};
template <class Epi, class Sched, bool ALIGN_EPI = false, bool SP2 = false>
__device__ __forceinline__ void gemm_phase(PG8_LAS unsigned char* lds, const Gemm g, const Sched& S, const Epi& E) {
    int tid = threadIdx.x; asm volatile("" : "+v"(tid)); const int wid = __builtin_amdgcn_readfirstlane(tid >> 6), lane = tid & 63, wr = wid >> 2, wc = wid & 3, fr = lane & 15, fq = lane >> 4;
    const int K = g.K, nt = K / BK;
    unsigned voffA[2], voffB[2];
#pragma unroll
    for (int i = 0; i < 2; ++i) { int R, C; stage_rc(tid * 16 + i * 8192, R, C); const int Rb = Epi::PERM ? ((R & ~31) + perm32(R & 31)) : R;
        voffA[i] = (unsigned)(R * K + C) * 2u; voffB[i] = (unsigned)(Rb * K + C) * 2u; }
    const size_t kstep = (size_t)(BK * 2);
    const size_t hstep = (size_t)HALF * K * 2;
    const size_t tstep = 2 * hstep;
    const unsigned ldsw = (unsigned)wid * 1024u;
    const int aoff = lds_byte(wr * 64 + fr, fq * 8), boff = lds_byte(wc * 32 + fr, fq * 8);
#define PG8_SA(b, h) (((b) * 2 + (h)) * HTB)
#define PG8_SB(b, h) ((4 + (b) * 2 + (h)) * HTB)
#define PG8_STAGE(bufoff, gbase, voff) do { _Pragma("unroll") for (int _i = 0; _i < 2; ++_i) \
        __builtin_amdgcn_global_load_lds((const unsigned*)((const char*)(gbase) + (voff)[_i]), (PG8_LAS unsigned*)(lds + (bufoff) + ldsw + _i * 8192), 16, 0, 0); } while (0)
#define PG8_LDA(dst, b, h) do { _Pragma("unroll") for (int m = 0; m < 4; ++m) _Pragma("unroll") for (int k = 0; k < 2; ++k) dst[m][k] = *(const PG8_LAS bf16x8*)(lds + PG8_SA(b, h) + aoff + m * 2048 + k * 1024); } while (0)
#define PG8_LDB(dst, b, h) do { _Pragma("unroll") for (int n = 0; n < 2; ++n) _Pragma("unroll") for (int k = 0; k < 2; ++k) dst[n][k] = *(const PG8_LAS bf16x8*)(lds + PG8_SB(b, h) + boff + n * 2048 + k * 1024); } while (0)
#define PG8_MMA(ai, bj, At, Bt) do { __builtin_amdgcn_s_setprio(1); _Pragma("unroll") for (int m = 0; m < 4; ++m) _Pragma("unroll") for (int n = 0; n < 2; ++n) _Pragma("unroll") for (int k = 0; k < 2; ++k) \
        acc[ai][bj][m][n] = __builtin_amdgcn_mfma_f32_16x16x32_bf16(Bt[n][k], At[m][k], acc[ai][bj][m][n], 0, 0, 0); __builtin_amdgcn_s_setprio(0); } while (0)
#define PG8_WAIT_V(n) asm volatile("s_waitcnt vmcnt(" #n ")" ::: "memory")
#define PG8_WAIT_L(n) asm volatile("s_waitcnt lgkmcnt(" #n ")" ::: "memory")
#define PG8_BAR __builtin_amdgcn_s_barrier()
#define PG8_SCHED __builtin_amdgcn_sched_barrier(0)
    Unit cur, nxt; int ui = 0;
    if (!S.next(0, cur)) return;
    f32x4 acc[2][2][4][2];
#pragma unroll
    for (int a = 0; a < 2; ++a)
#pragma unroll
        for (int b = 0; b < 2; ++b)
#pragma unroll
            for (int m = 0; m < 4; ++m)
#pragma unroll
                for (int n = 0; n < 2; ++n) acc[a][b][m][n] = (f32x4){0.f, 0.f, 0.f, 0.f};
    bf16x8 At[4][2], B0[2][2], B1[2][2];
    const char* cA = (const char*)g.A + (size_t)cur.pm * tstep; const char* cB = (const char*)g.Bt + (size_t)cur.pn * tstep;
    S.a_ready(cur);
    if constexpr (SP2) {
        PG8_STAGE(PG8_SB(0, 0), cB, voffB); PG8_STAGE(PG8_SB(0, 1), cB + hstep, voffB); PG8_STAGE(PG8_SA(0, 0), cA, voffA); PG8_STAGE(PG8_SA(0, 1), cA + hstep, voffA);
        if (wr == 1) PG8_BAR;
        PG8_WAIT_V(2); PG8_BAR;
        PG8_STAGE(PG8_SB(1, 0), cB + kstep, voffB); PG8_STAGE(PG8_SA(1, 0), cA + kstep, voffA); PG8_STAGE(PG8_SB(1, 1), cB + hstep + kstep, voffB);
        PG8_WAIT_V(6); PG8_BAR;
    } else {
        PG8_STAGE(PG8_SB(0, 0), cB, voffB); PG8_STAGE(PG8_SA(0, 0), cA, voffA); PG8_STAGE(PG8_SB(0, 1), cB + hstep, voffB); PG8_STAGE(PG8_SA(0, 1), cA + hstep, voffA);
        if (wr == 1) PG8_BAR;
        PG8_WAIT_V(4); PG8_BAR;
        PG8_STAGE(PG8_SB(1, 0), cB + kstep, voffB); PG8_STAGE(PG8_SA(1, 0), cA + kstep, voffA); PG8_STAGE(PG8_SB(1, 1), cB + hstep + kstep, voffB);
        PG8_WAIT_V(6); PG8_BAR;
    }
    for (;;) {
        const bool has_next = S.next(ui + 1, nxt);
        const char* nA = has_next ? (const char*)g.A + (size_t)nxt.pm * tstep : cA; const char* nB = has_next ? (const char*)g.Bt + (size_t)nxt.pn * tstep : cB;
        for (int t = 0; t < nt; t += 2) {
            const bool last = (t == nt - 2);
            const char* a1 = cA + (size_t)(t + 1) * kstep;
            const char* a2 = last ? nA : cA + (size_t)(t + 2) * kstep; const char* b2 = last ? nB : cB + (size_t)(t + 2) * kstep;
            const char* a3 = a2 + kstep; const char* b3 = b2 + kstep;
            if (last && has_next) S.a_ready(nxt);
            if constexpr (SP2) {
            PG8_LDB(B0, 0, 0); PG8_LDB(B1, 0, 1); PG8_SCHED; PG8_LDA(At, 0, 0); PG8_STAGE(PG8_SA(1, 1), a1 + hstep, voffA);
            PG8_WAIT_V(8); PG8_WAIT_L(0); PG8_BAR; PG8_MMA(0, 0, At, B0); PG8_MMA(0, 1, At, B1); PG8_BAR; PG8_SCHED;
            PG8_LDA(At, 0, 1); PG8_STAGE(PG8_SB(0, 0), b2, voffB); PG8_STAGE(PG8_SB(0, 1), b2 + hstep, voffB); PG8_STAGE(PG8_SA(0, 0), a2, voffA);
            PG8_WAIT_V(8); PG8_WAIT_L(0); PG8_BAR; PG8_MMA(1, 0, At, B0); PG8_MMA(1, 1, At, B1); PG8_BAR; PG8_SCHED;
            PG8_LDB(B0, 1, 0); PG8_LDB(B1, 1, 1); PG8_SCHED; PG8_LDA(At, 1, 0); PG8_STAGE(PG8_SA(0, 1), a2 + hstep, voffA);
            PG8_WAIT_V(8); PG8_WAIT_L(0); PG8_BAR; PG8_MMA(0, 0, At, B0); PG8_MMA(0, 1, At, B1); PG8_BAR; PG8_SCHED;
            PG8_LDA(At, 1, 1); PG8_STAGE(PG8_SB(1, 0), b3, voffB); PG8_STAGE(PG8_SB(1, 1), b3 + hstep, voffB); PG8_STAGE(PG8_SA(1, 0), a3, voffA);
            PG8_WAIT_V(8); PG8_WAIT_L(0); PG8_BAR; PG8_MMA(1, 0, At, B0); PG8_MMA(1, 1, At, B1); PG8_BAR; PG8_SCHED;
            } else {
            PG8_LDB(B0, 0, 0); PG8_SCHED; PG8_LDA(At, 0, 0); PG8_STAGE(PG8_SA(1, 1), a1 + hstep, voffA);
            PG8_WAIT_L(8); PG8_BAR; PG8_WAIT_L(0); PG8_MMA(0, 0, At, B0); PG8_BAR; PG8_SCHED;
            PG8_LDB(B1, 0, 1); PG8_STAGE(PG8_SB(0, 0), b2, voffB);
            PG8_BAR; PG8_WAIT_L(0); PG8_MMA(0, 1, At, B1); PG8_BAR;
            PG8_LDA(At, 0, 1); PG8_STAGE(PG8_SA(0, 0), a2, voffA);
            PG8_BAR; PG8_WAIT_L(0); PG8_MMA(1, 0, At, B0); PG8_BAR; PG8_SCHED;
            PG8_STAGE(PG8_SB(0, 1), b2 + hstep, voffB);
            PG8_WAIT_V(6); PG8_BAR; PG8_MMA(1, 1, At, B1); PG8_BAR;
            PG8_LDB(B0, 1, 0); PG8_SCHED; PG8_LDA(At, 1, 0); PG8_STAGE(PG8_SA(0, 1), a2 + hstep, voffA);
            PG8_WAIT_L(8); PG8_BAR; PG8_WAIT_L(0); PG8_MMA(0, 0, At, B0); PG8_BAR; PG8_SCHED;
            PG8_LDB(B1, 1, 1); PG8_STAGE(PG8_SB(1, 0), b3, voffB);
            PG8_BAR; PG8_WAIT_L(0); PG8_MMA(0, 1, At, B1); PG8_BAR;
            PG8_LDA(At, 1, 1); PG8_STAGE(PG8_SA(1, 0), a3, voffA);
            PG8_BAR; PG8_WAIT_L(0); PG8_MMA(1, 0, At, B0); PG8_BAR; PG8_SCHED;
            PG8_STAGE(PG8_SB(1, 1), b3 + hstep, voffB);
            PG8_WAIT_V(6); PG8_BAR; PG8_MMA(1, 1, At, B1); PG8_BAR;
            }
        }
        if constexpr (ALIGN_EPI) { if (wr == 0) PG8_BAR; }
        if constexpr (!Epi::AFTER_DRAIN) { E(acc, cur, wr, wc, fr, fq); S.done(cur); }
        if (!has_next) break;
#pragma unroll
        for (int a = 0; a < 2; ++a)
#pragma unroll
            for (int b = 0; b < 2; ++b)
#pragma unroll
                for (int m = 0; m < 4; ++m)
#pragma unroll
                    for (int n = 0; n < 2; ++n) acc[a][b][m][n] = (f32x4){0.f, 0.f, 0.f, 0.f};
        cur = nxt; cA = nA; cB = nB; ++ui;
        if constexpr (ALIGN_EPI) { if (wr == 1) PG8_BAR; }
    }
    PG8_WAIT_V(0);
    if constexpr (!ALIGN_EPI) { if (wr == 0) PG8_BAR; }
    PG8_BAR;
    if constexpr (Epi::AFTER_DRAIN) { E.fused(acc, cur, wr, wc, fr, fq, lds, wid, lane); S.done(cur); }
#undef PG8_SA
#undef PG8_SB
#undef PG8_STAGE
#undef PG8_LDA
#undef PG8_LDB
#undef PG8_MMA
#undef PG8_WAIT_V
#undef PG8_WAIT_L
#undef PG8_BAR
#undef PG8_SCHED
}
}

#define LAS __attribute__((address_space(3)))
typedef unsigned short bf16_t;
typedef short bf16x8 __attribute__((ext_vector_type(8)));
typedef float f32x4 __attribute__((ext_vector_type(4)));
typedef float f32x16 __attribute__((ext_vector_type(16)));
typedef unsigned u32x4 __attribute__((ext_vector_type(4)));
typedef unsigned u32x2 __attribute__((ext_vector_type(2)));

constexpr int DM = 1024, NBATCH = 16, SEQ = 2048, CTXL = 256, NLAYER = 2, DFF = 4096, INW = 2048;
constexpr int ML = NBATCH * SEQ, MC = NBATCH * CTXL, MT = ML + MC;
constexpr int NCHUNK = 36, KVLEN = CTXL + SEQ;
constexpr float EPS = 1e-6f, LOG2E = 1.4426950408889634f, QSCALE = 0.125f * 1.4426950408889634f;
constexpr int NPHASE = 2 + 8 * NLAYER;
constexpr int LDS_BYTES = 131072;

constexpr size_t MiB = 1u << 20;
constexpr size_t WS_CTL = 0, WS_MOD = 1 * MiB, WS_ROPE = 2 * MiB, WS_LRUW = 3 * MiB, WS_WIN = 4 * MiB, WS_WOUT = 12 * MiB, WS_W1 = 16 * MiB, WS_W2 = 32 * MiB,
                 WS_XC = 48 * MiB, WS_VT = 64 * MiB, WS_SUM = 82 * MiB, WS_H = 88 * MiB, WS_Z = 160 * MiB, WS_FEAT = 304 * MiB, WS_Y = 376 * MiB, WS_HID = 160 * MiB, WS_END = 448 * MiB;

enum { I_X = 0, I_C, I_CTX, I_CCTX, I_WMOD, I_BMOD, I_GPREMIX, I_GPOSTMIX, I_GPREMLP, I_GPOSTMLP, I_WIN, I_GQA, I_GKA, I_SINK, I_CONVW, I_CONVB, I_LWA, I_LBA, I_LWI, I_LBI, I_LLAM, I_WOUT, I_W1, I_W2, N_IN };
struct Args { const float* in[N_IN]; float* out; unsigned char* ws; int ph_lo, ph_hi; };

__device__ __forceinline__ unsigned cvt_pk(float lo, float hi) { unsigned r; asm("v_cvt_pk_bf16_f32 %0, %1, %2" : "=v"(r) : "v"(lo), "v"(hi)); return r; }
__device__ __forceinline__ float bf_lo(unsigned w) { return __uint_as_float(w << 16); }
__device__ __forceinline__ float bf_hi(unsigned w) { return __uint_as_float(w & 0xffff0000u); }
__device__ __forceinline__ void unpack8(const u32x4 w, float* v) { v[0] = bf_lo(w.x); v[1] = bf_hi(w.x); v[2] = bf_lo(w.y); v[3] = bf_hi(w.y); v[4] = bf_lo(w.z); v[5] = bf_hi(w.z); v[6] = bf_lo(w.w); v[7] = bf_hi(w.w); }
__device__ __forceinline__ u32x4 pack8(const float* v) { u32x4 w; w.x = cvt_pk(v[0], v[1]); w.y = cvt_pk(v[2], v[3]); w.z = cvt_pk(v[4], v[5]); w.w = cvt_pk(v[6], v[7]); return w; }
__device__ __forceinline__ float wave_sum(float v) {
#pragma unroll
    for (int o = 1; o < 64; o <<= 1) v += __shfl_xor(v, o);
    return v;
}
#define LDS_FENCE() asm volatile("s_waitcnt lgkmcnt(0)" ::: "memory")

__device__ __forceinline__ void transpose_item(const float* W, int K, int N, bf16_t* WT, float* scr, int item, int lane) {
    const int nblk = N / 32, kb = item / nblk, nb = item % nblk, k0 = 64 * kb, n0 = 32 * nb;
#pragma unroll 8
    for (int i = 0; i < 32; ++i) { const int kk = 2 * i + (lane >> 5); scr[kk * 33 + (lane & 31)] = W[(size_t)(k0 + kk) * N + n0 + (lane & 31)]; }
    LDS_FENCE();
    const int c = lane & 7;
#pragma unroll
    for (int j = 0; j < 4; ++j) { const int n = (lane >> 3) + 8 * j; const float* s = scr + (8 * c) * 33 + n;
        u32x4 o; o.x = cvt_pk(s[0 * 33], s[1 * 33]); o.y = cvt_pk(s[2 * 33], s[3 * 33]); o.z = cvt_pk(s[4 * 33], s[5 * 33]); o.w = cvt_pk(s[6 * 33], s[7 * 33]);
        *(u32x4*)(WT + (size_t)(n0 + n) * K + k0 + 8 * c) = o; }
    LDS_FENCE();
}

__device__ __forceinline__ void prologue_a(const Args& a, unsigned char* lds, int tid, int lane, int wave, int G) {
    float* scr = (float*)(lds + wave * 16384);
    const int gw = blockIdx.x * 8 + wave, NGW = G * 8;
    constexpr int I_IN = 16 * 64, I_OUT = 16 * 32, I_1 = 16 * 128, I_2 = 64 * 32, I_L = 64, NPER = I_IN + I_OUT + I_1 + I_2 + I_L;
    for (int it = gw; it < NLAYER * NPER; it += NGW) {
        const int l = it / NPER; int r = it - l * NPER;
        if (r < I_IN) { transpose_item(a.in[I_WIN] + (size_t)l * DM * INW, DM, INW, (bf16_t*)(a.ws + WS_WIN) + (size_t)l * INW * DM, scr, r, lane); continue; } r -= I_IN;
        if (r < I_OUT) { transpose_item(a.in[I_WOUT] + (size_t)l * DM * DM, DM, DM, (bf16_t*)(a.ws + WS_WOUT) + (size_t)l * DM * DM, scr, r, lane); continue; } r -= I_OUT;
        if (r < I_1) { transpose_item(a.in[I_W1] + (size_t)l * DM * DFF, DM, DFF, (bf16_t*)(a.ws + WS_W1) + (size_t)l * DFF * DM, scr, r, lane); continue; } r -= I_1;
        if (r < I_2) { transpose_item(a.in[I_W2] + (size_t)l * DFF * DM, DFF, DM, (bf16_t*)(a.ws + WS_W2) + (size_t)l * DM * DFF, scr, r, lane); continue; } r -= I_2;
        { const int mat = r >> 1, sub = r & 1, dir = mat >> 4, gate = (mat >> 3) & 1, h = mat & 7;
          const float* src = (gate ? a.in[I_LWI] : a.in[I_LWA]) + (size_t)(((l * 2 + dir) * 8 + h)) * 4096;
          bf16_t* dst = (bf16_t*)(a.ws + WS_LRUW) + (size_t)((((l * 2 + dir) * 2 + gate) * 8 + h)) * 4096;
          transpose_item(src, 64, 64, dst, scr, sub, lane); }
    }
    { const int gt = blockIdx.x * 512 + tid;
      if (gt < 96 * 16) { const int p = gt >> 4, i = gt & 15; const float inv = exp2f(-(float)i * 0.83048202372184058f); const float pos = (float)(p < 32 ? p : p - 32); const float ang = pos * inv;
          float* R = (float*)(a.ws + WS_ROPE); R[gt * 2] = __cosf(ang); R[gt * 2 + 1] = __sinf(ang); } }
    __syncthreads();
    if (blockIdx.x < 192) {
        float* act = (float*)lds; float* part = act + 17 * 1024; float* MOD = (float*)(a.ws + WS_MOD);
        for (int i = tid; i < 17 * 1024; i += 512) { const int r = i >> 10, k = i & 1023; const float c = r < 16 ? a.in[I_C][r * 1024 + k] : a.in[I_CCTX][k]; act[i] = c / (1.f + __expf(-c)); }
        __syncthreads();
        for (int bi = blockIdx.x; bi < 192; bi += G) {
            const int l = bi / 96, cb = bi % 96; const int n = cb * 64 + lane;
            const float* W = a.in[I_WMOD] + (size_t)l * DM * 6144 + n;
            float acc[17];
#pragma unroll
            for (int r = 0; r < 17; ++r) acc[r] = 0.f;
            const int k0 = wave * 128;
#pragma unroll 2
            for (int k = k0; k < k0 + 128; k += 4) {
                const float w0 = W[(size_t)k * 6144], w1 = W[(size_t)(k + 1) * 6144], w2 = W[(size_t)(k + 2) * 6144], w3 = W[(size_t)(k + 3) * 6144];
#pragma unroll
                for (int r = 0; r < 17; ++r) { const f32x4 av = *(const f32x4*)(act + r * 1024 + k); acc[r] += av.x * w0 + av.y * w1 + av.z * w2 + av.w * w3; }
            }
#pragma unroll
            for (int r = 0; r < 17; ++r) part[(wave * 17 + r) * 64 + lane] = acc[r];
            __syncthreads();
            for (int i = tid; i < 17 * 64; i += 512) { const int r = i >> 6, j = i & 63; float s = 0.f;
#pragma unroll
                for (int wv = 0; wv < 8; ++wv) s += part[(wv * 17 + r) * 64 + j];
                MOD[(size_t)(l * 17 + r) * 6144 + cb * 64 + j] = s + a.in[I_BMOD][l * 6144 + cb * 64 + j]; }
            __syncthreads();
        }
    }
}

__device__ __forceinline__ void rowpass(int lane, const float* xin, float* xout, const bf16_t* y, const float* gate, const float* gpost, const float* gpre, const float* sh, const float* sc, bf16_t* hout) {
    float xv[16];
#pragma unroll
    for (int j = 0; j < 2; ++j) { const int c0 = 8 * lane + 512 * j; const f32x4 p = *(const f32x4*)(xin + c0), q = *(const f32x4*)(xin + c0 + 4);
        xv[8 * j + 0] = p.x; xv[8 * j + 1] = p.y; xv[8 * j + 2] = p.z; xv[8 * j + 3] = p.w; xv[8 * j + 4] = q.x; xv[8 * j + 5] = q.y; xv[8 * j + 6] = q.z; xv[8 * j + 7] = q.w; }
    if (y) {
        float yv[16]; float ss = 0.f;
#pragma unroll
        for (int j = 0; j < 2; ++j) { const u32x4 w = *(const u32x4*)(y + 8 * lane + 512 * j); unpack8(w, yv + 8 * j); }
#pragma unroll
        for (int e = 0; e < 16; ++e) ss += yv[e] * yv[e];
        ss = wave_sum(ss); const float r = rsqrtf(ss * (1.f / DM) + EPS);
#pragma unroll
        for (int j = 0; j < 2; ++j) { const int c0 = 8 * lane + 512 * j;
#pragma unroll
            for (int e = 0; e < 8; ++e) xv[8 * j + e] += gate[c0 + e] * (yv[8 * j + e] * r * gpost[c0 + e]);
            *(f32x4*)(xout + c0) = (f32x4){xv[8 * j], xv[8 * j + 1], xv[8 * j + 2], xv[8 * j + 3]}; *(f32x4*)(xout + c0 + 4) = (f32x4){xv[8 * j + 4], xv[8 * j + 5], xv[8 * j + 6], xv[8 * j + 7]}; }
    }
    if (hout) {
        float ss = 0.f;
#pragma unroll
        for (int e = 0; e < 16; ++e) ss += xv[e] * xv[e];
        ss = wave_sum(ss); const float r = rsqrtf(ss * (1.f / DM) + EPS);
#pragma unroll
        for (int j = 0; j < 2; ++j) { const int c0 = 8 * lane + 512 * j; float hv[8];
#pragma unroll
            for (int e = 0; e < 8; ++e) hv[e] = (xv[8 * j + e] * r * gpre[c0 + e]) * (1.f + sc[c0 + e]) + sh[c0 + e];
            *(u32x4*)(hout + c0) = pack8(hv); }
    }
}

template <int DIR> __device__ __forceinline__ float dpp_prev(float v, int oldbits, int d) {
    const int iv = __builtin_bit_cast(int, v); int r;
    if (DIR == 0) { switch (d) { case 1: r = __builtin_amdgcn_update_dpp(oldbits, iv, 0x111, 0xf, 0xf, false); break; case 2: r = __builtin_amdgcn_update_dpp(oldbits, iv, 0x112, 0xf, 0xf, false); break;
                                  case 4: r = __builtin_amdgcn_update_dpp(oldbits, iv, 0x114, 0xf, 0xf, false); break; default: r = __builtin_amdgcn_update_dpp(oldbits, iv, 0x118, 0xf, 0xf, false); break; } }
    else           { switch (d) { case 1: r = __builtin_amdgcn_update_dpp(oldbits, iv, 0x101, 0xf, 0xf, false); break; case 2: r = __builtin_amdgcn_update_dpp(oldbits, iv, 0x102, 0xf, 0xf, false); break;
                                  case 4: r = __builtin_amdgcn_update_dpp(oldbits, iv, 0x104, 0xf, 0xf, false); break; default: r = __builtin_amdgcn_update_dpp(oldbits, iv, 0x108, 0xf, 0xf, false); break; } }
    return __builtin_bit_cast(float, r);
}

#define SCAN_STEP(SH, D) "v_fmac_f32_dpp %0, %0, %1 " SH ":" #D " row_mask:0xf bank_mask:0xf\n\tv_mul_f32_dpp %1, %1, %1 " SH ":" #D " row_mask:0xf bank_mask:0xf\n\ts_nop 1\n\t"
template <int DIR> __device__ __forceinline__ void scan16(float& a, float& u) {
    if (DIR == 0) asm volatile("s_nop 1\n\t" SCAN_STEP("row_shr", 1) SCAN_STEP("row_shr", 2) SCAN_STEP("row_shr", 4) SCAN_STEP("row_shr", 8) : "+v"(u), "+v"(a));
    else          asm volatile("s_nop 1\n\t" SCAN_STEP("row_shl", 1) SCAN_STEP("row_shl", 2) SCAN_STEP("row_shl", 4) SCAN_STEP("row_shl", 8) : "+v"(u), "+v"(a));
}
struct LruCtx { const Args* a; int l, b, c, w; int lane, tok, q; float* xc; long rowbase; int t0; };

__device__ __forceinline__ void lru_conv(const LruCtx& L) {
    const Args& a = *L.a; const int ch = L.w * 64 + L.lane;
    const bool isctx = L.c < 4; const int seqlen = isctx ? CTXL : SEQ;
    const float* cw = a.in[I_CONVW] + (size_t)L.l * 4 * 512 + ch; const float w0 = cw[0], w1 = cw[512], w2 = cw[1024], w3 = cw[1536], cb = a.in[I_CONVB][L.l * 512 + ch];
    const bf16_t* zc = (const bf16_t*)(a.ws + WS_Z) + (size_t)L.rowbase * INW + 1024 + ch;
#pragma unroll
    for (int T = 0; T < 4; ++T) {
        float zz[19];
#pragma unroll
        for (int i = 0; i < 19; ++i) { const int t = L.t0 + 16 * T - 2 + i; zz[i] = (t >= 0 && t < seqlen) ? __uint_as_float((unsigned)zc[(size_t)t * INW] << 16) : 0.f; }
#pragma unroll
        for (int i = 0; i < 16; ++i) L.xc[(16 * T + i) * 64 + (L.lane ^ (i << 2))] = cb + w0 * zz[i] + w1 * zz[i + 1] + w2 * zz[i + 2] + w3 * zz[i + 3];
    }
    LDS_FENCE();
}

template <bool FINAL, int DIR> __device__ __forceinline__ void lru_pass(const LruCtx& L, int nt, float (&hin)[4], float (&atot)[4], float (&hb)[4][4]) {
    const Args& a = *L.a; const int chb = L.w * 64 + 16 * nt + 4 * L.q;
    const bf16_t* Wa = (const bf16_t*)(a.ws + WS_LRUW) + (size_t)((((L.l * 2 + DIR) * 2 + 0) * 8 + L.w)) * 4096 + (16 * nt + L.tok) * 64 + 8 * L.q;
    const bf16_t* Wi = Wa + 8 * 4096;
    bf16x8 wa[2], wi[2];
#pragma unroll
    for (int ks = 0; ks < 2; ++ks) { wa[ks] = *(const bf16x8*)(Wa + 32 * ks); wi[ks] = *(const bf16x8*)(Wi + 32 * ks); }
    const int pofs = (L.l * 2 + DIR) * 512 + chb;
    const f32x4 ba = *(const f32x4*)(a.in[I_LBA] + pofs), bi = *(const f32x4*)(a.in[I_LBI] + pofs), lam = *(const f32x4*)(a.in[I_LLAM] + pofs);
    float sp[4];
#pragma unroll
    for (int r = 0; r < 4; ++r) { const float x = -lam[r]; const float spl = (x > 0.f ? x : 0.f) + log1pf(__expf(-fabsf(x))); sp[r] = 8.f * spl * LOG2E; }
#pragma unroll
    for (int Ti = 0; Ti < 4; ++Ti) {
        const int T = DIR == 0 ? Ti : 3 - Ti;
        const float* xrow = L.xc + (16 * T + L.tok) * 64; const int xsw = L.tok << 2;
        bf16x8 xb[2];
#pragma unroll
        for (int ks = 0; ks < 2; ++ks) { const f32x4 p = *(const f32x4*)(xrow + ((32 * ks + 8 * L.q) ^ xsw)), q = *(const f32x4*)(xrow + ((32 * ks + 8 * L.q + 4) ^ xsw));
            u32x4 w; w.x = cvt_pk(p.x, p.y); w.y = cvt_pk(p.z, p.w); w.z = cvt_pk(q.x, q.y); w.w = cvt_pk(q.z, q.w); xb[ks] = __builtin_bit_cast(bf16x8, w); }
        f32x4 aa = {0.f, 0.f, 0.f, 0.f}, ai = {0.f, 0.f, 0.f, 0.f};
        aa = __builtin_amdgcn_mfma_f32_16x16x32_bf16(wa[0], xb[0], aa, 0, 0, 0); aa = __builtin_amdgcn_mfma_f32_16x16x32_bf16(wa[1], xb[1], aa, 0, 0, 0);
        ai = __builtin_amdgcn_mfma_f32_16x16x32_bf16(wi[0], xb[0], ai, 0, 0, 0); ai = __builtin_amdgcn_mfma_f32_16x16x32_bf16(wi[1], xb[1], ai, 0, 0, 0);
        const f32x4 xo = *(const f32x4*)(xrow + ((16 * nt + 4 * L.q) ^ xsw));
        float hv[4];
#pragma unroll
        for (int r = 0; r < 4; ++r) {
            const float rg = __builtin_amdgcn_rcpf(1.f + __builtin_amdgcn_exp2f(-(aa[r] + ba[r]) * LOG2E));
            const float ig = __builtin_amdgcn_rcpf(1.f + __builtin_amdgcn_exp2f(-(ai[r] + bi[r]) * LOG2E));
            float av = __builtin_amdgcn_exp2f(-rg * sp[r]);
            float om = 1.f - av * av; om = om > 0.f ? om : 0.f;
            float uv = __builtin_amdgcn_sqrtf(om) * (ig * xo[r]);
            scan16<DIR>(av, uv);
            const float h = av * hin[r] + uv;
            const int src = (L.lane & 48) | (DIR == 0 ? 15 : 0);
            hin[r] = __shfl(h, src);
            if (!FINAL) atot[r] *= __shfl(av, src);
            hv[r] = h;
        }
        if (FINAL) {
            if (DIR == 1) {
#pragma unroll
                for (int r = 0; r < 4; ++r) hb[T][r] = hv[r];
            } else {
                const long row = L.rowbase + L.t0 + 16 * T + L.tok;
                const u32x2 gw = *(const u32x2*)((const bf16_t*)(a.ws + WS_Z) + (size_t)row * INW + 1536 + chb);
                const float g[4] = {bf_lo(gw.x), bf_hi(gw.x), bf_lo(gw.y), bf_hi(gw.y)}; float o[4];
#pragma unroll
                for (int r = 0; r < 4; ++r) { const float x = g[r]; const float ge = x / (1.f + __builtin_amdgcn_exp2f(-2.f * 0.7978845608028654f * LOG2E * (x + 0.044715f * x * x * x))); o[r] = (hv[r] + hb[T][r]) * ge; }
                u32x2 ow; ow.x = cvt_pk(o[0], o[1]); ow.y = cvt_pk(o[2], o[3]);
                *(u32x2*)((bf16_t*)(a.ws + WS_FEAT) + (size_t)row * DM + 512 + chb) = ow;
            }
        }
    }
}

__device__ __forceinline__ void lru_setup(LruCtx& L, const Args& a, int l, int it, int lane, float* xc) {
    L.a = &a; L.l = l; L.b = it / (NCHUNK * 8); const int rem = it - L.b * (NCHUNK * 8); L.c = rem >> 3; L.w = rem & 7; L.lane = lane; L.tok = lane & 15; L.q = lane >> 4; L.xc = xc;
    const bool isctx = L.c < 4; L.rowbase = isctx ? (long)ML + L.b * CTXL : (long)L.b * SEQ; L.t0 = isctx ? L.c * 64 : (L.c - 4) * 64;
}

__device__ __forceinline__ void lru_summary_item(const Args& a, int l, int it, int lane, float* xc) {
    LruCtx L; lru_setup(L, a, l, it, lane, xc);
    lru_conv(L);
    float* SUM = (float*)(a.ws + WS_SUM);
    float hb[4][4];
#pragma unroll 1
    for (int nt = 0; nt < 4; ++nt) {
        const int chb = L.w * 64 + 16 * nt + 4 * L.q;
        { float hin[4] = {0.f, 0.f, 0.f, 0.f}, at[4] = {1.f, 1.f, 1.f, 1.f}; lru_pass<false, 0>(L, nt, hin, at, hb);
#ifdef DBG_XC
          { const int cl = 16 * nt + 4 * L.q; const f32x4 x0 = *(const f32x4*)(L.xc + 5 * 64 + (cl ^ (5 << 2))), x1 = *(const f32x4*)(L.xc + 63 * 64 + (cl ^ (15 << 2)));
            at[0] = x0[0]; at[1] = x0[1]; at[2] = x0[2]; at[3] = x0[3]; hin[0] = x1[0]; hin[1] = x1[1]; hin[2] = x1[2]; hin[3] = x1[3]; }
#endif
          if (L.tok == 0) { float* p = SUM + (size_t)(((L.b * NCHUNK + L.c) * 2 + 0) * 2) * 512 + chb; *(f32x4*)p = (f32x4){at[0], at[1], at[2], at[3]}; *(f32x4*)(p + 512) = (f32x4){hin[0], hin[1], hin[2], hin[3]}; } }
        { float hin[4] = {0.f, 0.f, 0.f, 0.f}, at[4] = {1.f, 1.f, 1.f, 1.f}; lru_pass<false, 1>(L, nt, hin, at, hb);
#ifdef DBG_XC2
          { const int cl = 16 * nt + 4 * L.q; const f32x4 x0 = *(const f32x4*)(L.xc + 5 * 64 + (cl ^ (5 << 2))), x1 = *(const f32x4*)(L.xc + 63 * 64 + (cl ^ (15 << 2)));
            at[0] = x0[0]; at[1] = x0[1]; at[2] = x0[2]; at[3] = x0[3]; hin[0] = x1[0]; hin[1] = x1[1]; hin[2] = x1[2]; hin[3] = x1[3]; }
#endif
          if (L.tok == 0) { float* p = SUM + (size_t)(((L.b * NCHUNK + L.c) * 2 + 1) * 2) * 512 + chb; *(f32x4*)p = (f32x4){at[0], at[1], at[2], at[3]}; *(f32x4*)(p + 512) = (f32x4){hin[0], hin[1], hin[2], hin[3]}; } }
    }
    LDS_FENCE();
}

__device__ __forceinline__ void lru_fold(const float* SUM, int b, int j, int dir, int chb, float (&h)[4]) {
    const float* p = SUM + (size_t)(((b * NCHUNK + j) * 2 + dir) * 2) * 512 + chb; const f32x4 A = *(const f32x4*)p, H = *(const f32x4*)(p + 512);
#pragma unroll
    for (int r = 0; r < 4; ++r) h[r] = A[r] * h[r] + H[r];
}

__device__ __forceinline__ void lru_final_item(const Args& a, int l, int it, int lane, float* xc) {
    LruCtx L; lru_setup(L, a, l, it, lane, xc);
    lru_conv(L);
    const float* SUM = (const float*)(a.ws + WS_SUM);
    float hb[4][4], at[4] = {1.f, 1.f, 1.f, 1.f};
#pragma unroll 1
    for (int nt = 0; nt < 4; ++nt) {
        const int chb = L.w * 64 + 16 * nt + 4 * L.q;
        float hf[4] = {0.f, 0.f, 0.f, 0.f}, hbk[4] = {0.f, 0.f, 0.f, 0.f};
        for (int j = 0; j < L.c; ++j) lru_fold(SUM, L.b, j, 0, chb, hf);
        if (L.c < 4) { for (int j = 3; j > L.c; --j) lru_fold(SUM, L.b, j, 1, chb, hbk); }
        else { for (int j = 3; j >= 0; --j) lru_fold(SUM, L.b, j, 1, chb, hbk); for (int j = NCHUNK - 1; j > L.c; --j) lru_fold(SUM, L.b, j, 1, chb, hbk); }
        lru_pass<true, 1>(L, nt, hbk, at, hb);
        lru_pass<true, 0>(L, nt, hf, at, hb);
    }
    LDS_FENCE();
}

__device__ __forceinline__ void phase_prep(const Args& a, int l, unsigned char* lds, int lane, int wave, int G) {
    const int gw = blockIdx.x * 8 + wave, NGW = G * 8;
    bf16_t* Z = (bf16_t*)(a.ws + WS_Z);
    for (int it = gw; it < NBATCH * NCHUNK * 8; it += NGW) lru_summary_item(a, l, it, lane, (float*)(lds + wave * 16384));
    { bf16_t* tile = (bf16_t*)(lds + wave * 16384); bf16_t* VT = (bf16_t*)(a.ws + WS_VT);
      for (int it0 = gw; it0 < (MT / 64) * 4; it0 += NGW) {
          const int it = it0; const int tt = it >> 2, which = it & 3; const int row0 = tt * 64; int b, pos0;
          if (row0 < ML) { b = row0 >> 11; pos0 = CTXL + (row0 & 2047); } else { const int r = row0 - ML; b = r >> 8; pos0 = r & 255; }
          const int col0 = which < 2 ? 384 + which * 64 : 896 + (which - 2) * 64;
#pragma unroll
          for (int i = 0; i < 8; ++i) { const int tok = i * 8 + (lane >> 3); const u32x4 w = *(const u32x4*)(Z + (size_t)(row0 + tok) * INW + col0 + 8 * (lane & 7)); *(u32x4*)(tile + tok * 72 + 8 * (lane & 7)) = w; }
          LDS_FENCE();
          bf16_t* dst = VT + (size_t)((b * 4 + which) * 64 + lane) * KVLEN + pos0;
#pragma unroll
          for (int g = 0; g < 8; ++g) { u32x4 o;
              o.x = (unsigned)tile[(8 * g + 0) * 72 + lane] | ((unsigned)tile[(8 * g + 1) * 72 + lane] << 16); o.y = (unsigned)tile[(8 * g + 2) * 72 + lane] | ((unsigned)tile[(8 * g + 3) * 72 + lane] << 16);
              o.z = (unsigned)tile[(8 * g + 4) * 72 + lane] | ((unsigned)tile[(8 * g + 5) * 72 + lane] << 16); o.w = (unsigned)tile[(8 * g + 6) * 72 + lane] | ((unsigned)tile[(8 * g + 7) * 72 + lane] << 16);
              *(u32x4*)(dst + 8 * g) = o; }
          LDS_FENCE();
      } }
    { const float* ROPE = (const float*)(a.ws + WS_ROPE); const int e8 = lane & 7;
      for (int it = gw; it < MT * 12 / 8; it += NGW) {
          const int idx = it * 8 + (lane >> 3); const int m = idx / 12, hs = idx - m * 12;
          const int col0 = hs < 4 ? hs * 64 : hs < 6 ? 256 + (hs - 4) * 64 : hs < 10 ? 512 + (hs - 6) * 64 : 768 + (hs - 10) * 64;
          const bool lat = m < ML, isq = hs < 4 || (hs >= 6 && hs < 10), nrm = hs < 6;
          bf16_t* p = Z + (size_t)m * INW + col0 + 8 * e8;
          float v[8]; unpack8(*(const u32x4*)p, v);
          if (nrm) { float ss = 0.f;
#pragma unroll
              for (int e = 0; e < 8; ++e) ss += v[e] * v[e];
              ss += __shfl_xor(ss, 1); ss += __shfl_xor(ss, 2); ss += __shfl_xor(ss, 4);
              const float r = rsqrtf(ss * (1.f / 64.f) + EPS); const float* g = (hs < 4 ? a.in[I_GQA] : a.in[I_GKA]) + l * 64 + 8 * e8;
#pragma unroll
              for (int e = 0; e < 8; ++e) v[e] = v[e] * r * g[e]; }
          if (lat) { const int t = m & 2047; const int pp = e8 < 4 ? (t >> 6) : 32 + (t & 63); const float* tb = ROPE + (pp * 16 + 8 * (e8 & 1)) * 2;
#pragma unroll
              for (int e = 0; e < 8; ++e) { const float pv = __shfl_xor(v[e], 2); const float cs = tb[2 * e], sn = tb[2 * e + 1]; v[e] = (e8 & 2) ? v[e] * cs + pv * sn : v[e] * cs - pv * sn; } }
          if (isq) {
#pragma unroll
              for (int e = 0; e < 8; ++e) v[e] *= QSCALE; }
          *(u32x4*)p = pack8(v);
      } }
}

__device__ __forceinline__ int crow(int r, int hi) { return (r & 3) + 8 * (r >> 2) + 4 * hi; }
__device__ __forceinline__ void attn_unit(const Args& a, int l, int type, int b, int kvh, int qt, unsigned char* lds, int tid, int lane, int wid) {
    const bool isB = type & 1, isCtx = type >> 1;
    const int r32 = lane & 31, hi = lane >> 5, head = kvh * 2 + (wid >> 2);
    const int qpos = qt * 128 + (wid & 3) * 32 + r32;
    const long qrow = isCtx ? (long)ML + b * CTXL + qpos : (long)b * SEQ + qpos;
    const bf16_t* Z = (const bf16_t*)(a.ws + WS_Z);
    const int kcol = (isB ? 768 : 256) + kvh * 64;
    const bf16_t* vt = (const bf16_t*)(a.ws + WS_VT) + (size_t)((b * 4 + (isB ? 2 : 0) + kvh) * 64) * KVLEN;
    int lt_lo = 0, n_lat = 0;
    if (!isCtx) { if (!isB) { lt_lo = 0; n_lat = 32; } else { lt_lo = 2 * qt - 2 < 0 ? 0 : 2 * qt - 2; const int lt_hi = 2 * qt + 3 > 31 ? 31 : 2 * qt + 3; n_lat = lt_hi - lt_lo + 1; } }
    const int NT = 4 + n_lat;
    bf16x8 qr[4];
    { const bf16_t* qp = Z + (size_t)qrow * INW + (isB ? 512 : 0) + head * 64 + 8 * hi;
#pragma unroll
      for (int ks = 0; ks < 4; ++ks) qr[ks] = *(const bf16x8*)(qp + 16 * ks); }
    float m_run = -1e30f, l_run = 0.f;
    if (isB) { m_run = a.in[I_SINK][l * 4 + head] * LOG2E; l_run = hi == 0 ? 1.f : 0.f; }
    f32x16 o[2];
#pragma unroll
    for (int r = 0; r < 16; ++r) { o[0][r] = 0.f; o[1][r] = 0.f; }
    const int srow = tid >> 3, sch = tid & 7;
    const int soff = srow * 144 + sch * 16;
    u32x4 kreg, vreg;
#define ATT_KT(t) ((t) < 4 ? (t) : 4 + lt_lo + (t) - 4)
#define ATT_LOAD(t) do { const int kt_ = ATT_KT(t); const long krow_ = kt_ < 4 ? (long)ML + b * CTXL + kt_ * 64 + srow : (long)b * SEQ + (kt_ - 4) * 64 + srow; \
        kreg = *(const u32x4*)(Z + (size_t)krow_ * INW + kcol + 8 * sch); vreg = *(const u32x4*)(vt + (size_t)srow * KVLEN + kt_ * 64 + 8 * sch); } while (0)
#define ATT_STORE(buf) do { *(u32x4*)(lds + (buf) * 18432 + soff) = kreg; *(u32x4*)(lds + (buf) * 18432 + 9216 + soff) = vreg; } while (0)
    ATT_LOAD(0); ATT_STORE(0); __syncthreads();
    for (int t = 0; t < NT; ++t) {
        const bool more = t + 1 < NT;
        if (more) ATT_LOAD(t + 1);
        const unsigned char* Kl = lds + (t & 1) * 18432; const unsigned char* Vl = Kl + 9216;
        f32x16 s0, s1;
#pragma unroll
        for (int r = 0; r < 16; ++r) { s0[r] = 0.f; s1[r] = 0.f; }
#pragma unroll
        for (int ks = 0; ks < 4; ++ks) {
            const bf16x8 k0 = *(const bf16x8*)(Kl + r32 * 144 + (16 * ks + 8 * hi) * 2), k1 = *(const bf16x8*)(Kl + (32 + r32) * 144 + (16 * ks + 8 * hi) * 2);
            s0 = __builtin_amdgcn_mfma_f32_32x32x16_bf16(k0, qr[ks], s0, 0, 0, 0); s1 = __builtin_amdgcn_mfma_f32_32x32x16_bf16(k1, qr[ks], s1, 0, 0, 0);
        }
        if (isB && t >= 4) { const int kp0 = (ATT_KT(t) - 4) * 64 - qpos;
#pragma unroll
            for (int r = 0; r < 16; ++r) { const int d0 = kp0 + crow(r, hi); if (d0 > 128 || d0 < -128) s0[r] = -1e30f; const int d1 = d0 + 32; if (d1 > 128 || d1 < -128) s1[r] = -1e30f; } }
        float mx = s0[0];
#pragma unroll
        for (int r = 1; r < 16; ++r) mx = fmaxf(mx, s0[r]);
#pragma unroll
        for (int r = 0; r < 16; ++r) mx = fmaxf(mx, s1[r]);
        mx = fmaxf(mx, __shfl_xor(mx, 32));
        const float mnew = fmaxf(m_run, mx); const float alpha = __builtin_amdgcn_exp2f(m_run - mnew); m_run = mnew;
        float ps = 0.f;
#pragma unroll
        for (int r = 0; r < 16; ++r) { s0[r] = __builtin_amdgcn_exp2f(s0[r] - mnew); s1[r] = __builtin_amdgcn_exp2f(s1[r] - mnew); ps += s0[r] + s1[r]; }
        l_run = l_run * alpha + ps;
#pragma unroll
        for (int r = 0; r < 16; ++r) { o[0][r] *= alpha; o[1][r] *= alpha; }
        bf16x8 pk[2][2];
#pragma unroll
        for (int s = 0; s < 2; ++s) {
            u32x4 w0, w1;
            w0.x = cvt_pk(s0[8 * s + 0], s0[8 * s + 1]); w0.y = cvt_pk(s0[8 * s + 2], s0[8 * s + 3]); w0.z = cvt_pk(s0[8 * s + 4], s0[8 * s + 5]); w0.w = cvt_pk(s0[8 * s + 6], s0[8 * s + 7]);
            w1.x = cvt_pk(s1[8 * s + 0], s1[8 * s + 1]); w1.y = cvt_pk(s1[8 * s + 2], s1[8 * s + 3]); w1.z = cvt_pk(s1[8 * s + 4], s1[8 * s + 5]); w1.w = cvt_pk(s1[8 * s + 6], s1[8 * s + 7]);
            pk[0][s] = __builtin_bit_cast(bf16x8, w0); pk[1][s] = __builtin_bit_cast(bf16x8, w1);
        }
#pragma unroll
        for (int dh = 0; dh < 2; ++dh)
#pragma unroll
            for (int kh = 0; kh < 2; ++kh)
#pragma unroll
                for (int s = 0; s < 2; ++s) {
                    const unsigned char* vp = Vl + (32 * dh + r32) * 144 + (32 * kh + 16 * s + 4 * hi) * 2;
                    const u32x2 lo = *(const u32x2*)vp, hh = *(const u32x2*)(vp + 16);
                    const u32x4 vv = {lo.x, lo.y, hh.x, hh.y};
                    o[dh] = __builtin_amdgcn_mfma_f32_32x32x16_bf16(__builtin_bit_cast(bf16x8, vv), pk[kh][s], o[dh], 0, 0, 0);
                }
        if (more) ATT_STORE((t + 1) & 1);
        __syncthreads();
    }
#undef ATT_KT
#undef ATT_LOAD
#undef ATT_STORE
    const float lt = l_run + __shfl_xor(l_run, 32); const float inv = 1.f / lt;
    bf16_t* fp = (bf16_t*)(a.ws + WS_FEAT) + (size_t)qrow * DM + (isB ? 256 : 0) + head * 64 + 4 * hi;
#pragma unroll
    for (int dh = 0; dh < 2; ++dh)
#pragma unroll
        for (int rq = 0; rq < 4; ++rq) { u32x2 w; w.x = cvt_pk(o[dh][4 * rq] * inv, o[dh][4 * rq + 1] * inv); w.y = cvt_pk(o[dh][4 * rq + 2] * inv, o[dh][4 * rq + 3] * inv);
            *(u32x2*)(fp + 32 * dh + 8 * rq) = w; }
}

__device__ __forceinline__ void phase_mix(const Args& a, int l, unsigned char* lds, int tid, int lane, int wave, int G) {
    const int NA = NBATCH * 2 * 16, NC = l == 0 ? NBATCH * 2 * 2 : 0;
    const int total = 2 * NA + 2 * NC;
    for (int u = blockIdx.x; u < total; u += G) {
        int type, r = u;
        if (r < NA) type = 0; else if (r < 2 * NA) { type = 1; r -= NA; } else if (r < 2 * NA + NC) { type = 2; r -= 2 * NA; } else { type = 3; r -= 2 * NA + NC; }
        int b, kvh, qt;
        if (type < 2) { b = r >> 5; kvh = (r >> 4) & 1; qt = r & 15; } else { b = r >> 2; kvh = (r >> 1) & 1; qt = r & 1; }
#ifndef NO_ATT
        attn_unit(a, l, type, b, kvh, qt, lds, tid, lane, wave);
#endif
    }
    __syncthreads();
    const int gw = blockIdx.x * 8 + wave, NGW = G * 8;
    for (int it = gw; it < NBATCH * NCHUNK * 8; it += NGW) {
        const int c = (it % (NCHUNK * 8)) >> 3;
        if (l == NLAYER - 1 && c < 4) continue;
#ifndef NO_LRUF
        lru_final_item(a, l, it, lane, (float*)(lds + wave * 16384));
#endif
    }
}

__global__ void __launch_bounds__(512, 2) fwd_kernel(Args a) {
    extern __shared__ __attribute__((aligned(16))) unsigned char lds[];
    cg::grid_group grid = cg::this_grid();
    const int G = gridDim.x, NGW = G * 8;
    const float* MOD = (const float*)(a.ws + WS_MOD);
    bf16_t* H = (bf16_t*)(a.ws + WS_H); bf16_t* Zb = (bf16_t*)(a.ws + WS_Z); bf16_t* FEAT = (bf16_t*)(a.ws + WS_FEAT); bf16_t* Y = (bf16_t*)(a.ws + WS_Y); bf16_t* HID = (bf16_t*)(a.ws + WS_HID);
    float* XC = (float*)(a.ws + WS_XC);
    for (int ph = a.ph_lo; ph < a.ph_hi; ++ph) {
        if (ph > a.ph_lo) grid.sync();
        int tid = threadIdx.x; asm volatile("" : "+v"(tid)); const int lane = tid & 63, wave = __builtin_amdgcn_readfirstlane(tid >> 6); const int gw = blockIdx.x * 8 + wave;
        if (ph == 0) {
#ifndef NO_PRO
 prologue_a(a, lds, tid, lane, wave, G);
#endif
 continue; }
        if (ph == 1) {
            for (int m = gw; m < MT; m += NGW) { const bool lat = m < ML; const float* xin = lat ? a.in[I_X] + (size_t)m * DM : a.in[I_CTX] + (size_t)(m - ML) * DM;
                const float* mod = MOD + (size_t)(0 * 17 + (lat ? (m >> 11) : 16)) * 6144;
                rowpass(lane, xin, nullptr, nullptr, nullptr, nullptr, a.in[I_GPREMIX], mod, mod + 1024, H + (size_t)m * DM); }
            continue;
        }
        const int l = (ph - 2) >> 3, k = (ph - 2) & 7;
        const int Mrows = (l == NLAYER - 1) ? ML : MT;
#ifndef NO_GEMM
        if (k == 0 || k == 3 || k == 6) {
            pg8::Gemm g; bf16_t* O; int ldc;
            if (k == 0) { g = pg8::Gemm{H, (const bf16_t*)(a.ws + WS_WIN) + (size_t)l * INW * DM, MT, INW, DM}; O = Zb; ldc = INW; }
            else if (k == 3) { g = pg8::Gemm{FEAT, (const bf16_t*)(a.ws + WS_WOUT) + (size_t)l * DM * DM, Mrows, DM, DM}; O = Y; ldc = DM; }
            else { g = pg8::Gemm{HID, (const bf16_t*)(a.ws + WS_W2) + (size_t)l * DM * DFF, Mrows, DM, DFF}; O = H; ldc = DM; }
            pg8::StaticOrder S; S.init(g.M, g.N, G, (int)blockIdx.x);
            pg8::EpiStore<0> E{O, ldc};
            pg8::gemm_phase<pg8::EpiStore<0>, pg8::StaticOrder, true, true>((LAS unsigned char*)lds, g, S, E);
        } else if (k == 5) {
            pg8::Gemm g{H, (const bf16_t*)(a.ws + WS_W1) + (size_t)l * DFF * DM, Mrows, DFF, DM};
            pg8::StaticOrder S; S.init(g.M, g.N, G, (int)blockIdx.x);
            pg8::EpiStore<2> E{HID, DFF};
            pg8::gemm_phase<pg8::EpiStore<2>, pg8::StaticOrder, true, true>((LAS unsigned char*)lds, g, S, E);
        } else
#endif
        if (k == 1) {
#ifndef NO_PREP
 phase_prep(a, l, lds, lane, wave, G);
#endif

        } else if (k == 2) {
#ifndef NO_MIX
 phase_mix(a, l, lds, tid, lane, wave, G);
#endif

        } else {
            const bool first = (k == 4);
            const bool last = (!first && l == NLAYER - 1);
            for (int m = gw; m < Mrows; m += NGW) { const bool lat = m < ML;
                const float* xin; float* xout;
                if (lat) { xout = a.out + (size_t)m * DM; xin = (first && l == 0) ? a.in[I_X] + (size_t)m * DM : xout; }
                else { xout = XC + (size_t)(m - ML) * DM; xin = (first && l == 0) ? a.in[I_CTX] + (size_t)(m - ML) * DM : xout; }
                const float* mod = MOD + (size_t)(l * 17 + (lat ? (m >> 11) : 16)) * 6144;
                if (first) rowpass(lane, xin, xout, Y + (size_t)m * DM, mod + 2048, a.in[I_GPOSTMIX] + l * DM, a.in[I_GPREMLP] + l * DM, mod + 3072, mod + 4096, H + (size_t)m * DM);
                else { const float* modn = MOD + (size_t)((l + 1) * 17 + (lat ? (m >> 11) : 16)) * 6144;
                    rowpass(lane, xin, xout, H + (size_t)m * DM, mod + 5120, a.in[I_GPOSTMLP] + l * DM, last ? nullptr : a.in[I_GPREMIX] + (l + 1) * DM, modn, modn + 1024, last ? nullptr : H + (size_t)m * DM); }
            }
        }
    }
#ifdef DBG_STOP
    grid.sync();
    { const int tid = threadIdx.x; const size_t gt = (size_t)blockIdx.x * 512 + tid, NT_ = (size_t)G * 512;
      for (size_t i = gt; i < (size_t)ML * DM; i += NT_) { const size_t m = i >> 10, c = i & 1023; float v = 0.f;
#if DBG_SRC == 0
          v = bf_lo(H[m * DM + c]) + (m < MC ? bf_lo(H[(ML + m) * DM + c]) : 0.f);
#elif DBG_SRC == 1
          v = bf_lo(Zb[m * INW + c]) + bf_lo(Zb[m * INW + 1024 + c]) + (m < MC ? bf_lo(Zb[(ML + m) * INW + c]) + bf_lo(Zb[(ML + m) * INW + 1024 + c]) : 0.f);
#elif DBG_SRC == 2
          v = bf_lo(FEAT[m * DM + c]) + (m < MC ? bf_lo(FEAT[(ML + m) * DM + c]) : 0.f);
#elif DBG_SRC == 3
          { const bf16_t* VT = (const bf16_t*)(a.ws + WS_VT); const float* SUM = (const float*)(a.ws + WS_SUM); v = (i < (size_t)NBATCH * 4 * 64 * KVLEN ? bf_lo(VT[i]) : 0.f) + (i < (size_t)NBATCH * NCHUNK * 2 * 2 * 512 ? SUM[i] : 0.f); }
#elif DBG_SRC == 5
          v = bf_lo(Zb[m * INW + c]) + bf_lo(Zb[m * INW + 1024 + c]) + (m < MC ? bf_lo(Zb[(ML + m) * INW + c]) + bf_lo(Zb[(ML + m) * INW + 1024 + c]) : 0.f);
          { const bf16_t* VT = (const bf16_t*)(a.ws + WS_VT); const float* SUM = (const float*)(a.ws + WS_SUM); v += (i < (size_t)NBATCH * 4 * 64 * KVLEN ? bf_lo(VT[i]) : 0.f) + (i < (size_t)NBATCH * NCHUNK * 2 * 2 * 512 ? SUM[i] : 0.f); }
#elif DBG_SRC == 6
          { const float* SUM = (const float*)(a.ws + WS_SUM); v = (i < (size_t)NBATCH * NCHUNK * 2 * 2 * 512 ? SUM[i] : 0.f); }
#elif DBG_SRC == 7
          { const bf16_t* VT = (const bf16_t*)(a.ws + WS_VT); v = (i < (size_t)NBATCH * 4 * 64 * KVLEN ? bf_lo(VT[i]) : 0.f); }
#elif DBG_SRC == 8
          { const float* SUM = (const float*)(a.ws + WS_SUM); v = (i < (size_t)NBATCH * NCHUNK * 2 * 2 * 512 ? SUM[i] : 0.f); if (!(fabsf(v) < 1e30f)) v = 12345.f; }
#elif DBG_SRC == 9
          { const bf16_t* LW = (const bf16_t*)(a.ws + WS_LRUW); const float* RP = (const float*)(a.ws + WS_ROPE);
            v = (i < 262144 ? bf_lo(LW[i]) : 0.f) + (i < 208896 ? MOD[i] : 0.f) + (i < 3072 ? RP[i] : 0.f); }
#elif DBG_SRC == 4
          v = bf_lo(Y[m * DM + c]) + (m < MC ? bf_lo(Y[(ML + m) * DM + c]) : 0.f);
#endif
          a.out[i] = v; } }
#endif
}

extern "C" void kernel_launch(void* const* d_in, const int* in_sizes, int n_in, void* d_out, int out_size, void* d_ws, size_t ws_size, hipStream_t stream) {
    static int grid = 0;
    if (grid == 0) {
        if (n_in != N_IN || ws_size < WS_END) { fprintf(stderr, "kernel_launch: unexpected n_in %d or ws_size %zu\n", n_in, ws_size); grid = -1; return; }
        int dev = 0, cus = 0, per_cu = 0;
        hipGetDevice(&dev); hipDeviceGetAttribute(&cus, hipDeviceAttributeMultiprocessorCount, dev);
        hipFuncSetAttribute((const void*)fwd_kernel, hipFuncAttributeMaxDynamicSharedMemorySize, LDS_BYTES);
        if (hipOccupancyMaxActiveBlocksPerMultiprocessor(&per_cu, (const void*)fwd_kernel, 512, LDS_BYTES) != hipSuccess || per_cu < 1) per_cu = 1;
        (void)hipGetLastError();
        grid = cus * 1;
        if (grid <= 0) grid = 256;
    }
    if (grid < 0) return;
    Args a{};
    for (int i = 0; i < N_IN; ++i) a.in[i] = (const float*)d_in[i];
    a.out = (float*)d_out; a.ws = (unsigned char*)d_ws;
#if MK_MULTI
    for (int ph = 0; ph < NPHASE; ++ph) { a.ph_lo = ph; a.ph_hi = ph + 1; hipLaunchKernelGGL(fwd_kernel, dim3(grid), dim3(512), LDS_BYTES, stream, a); }
#else
#ifdef DBG_STOP
    a.ph_lo = 0; a.ph_hi = DBG_STOP;
#else
    a.ph_lo = 0; a.ph_hi = NPHASE;
#endif
    void* args[] = {&a};
    hipError_t e = hipLaunchCooperativeKernel((const void*)fwd_kernel, dim3(grid), dim3(512), args, LDS_BYTES, stream);
    if (e != hipSuccess) fprintf(stderr, "cooperative launch failed: %s (grid %d)\n", hipGetErrorString(e), grid);
#endif
}
```

```cpp
#include <hip/hip_runtime.h>
#include <hip/hip_cooperative_groups.h>
#include <cstdio>
#include <cstdint>
namespace cg = cooperative_groups;
#ifndef MK_MULTI
#define MK_MULTI 0
#endif
namespace pg8 {
#define PG8_LAS __attribute__((address_space(3)))
typedef unsigned short bf16_t;
typedef short bf16x8 __attribute__((ext_vector_type(8)));
typedef float f32x4 __attribute__((ext_vector_type(4)));
typedef unsigned u32x4 __attribute__((ext_vector_type(4)));
constexpr int BM = 256, BK = 64, HALF = 128, HTB = HALF * BK * 2  , STAGE_BYTES = 8 * HTB, NXCD = 8, WGM = 8;

__host__ __device__ __forceinline__ int lds_byte(int r, int c) { const int st = (r >> 4) * 2 + (c >> 5), rr = r & 15, cc = c & 31, ob = rr * 64 + cc * 2; return st * 1024 + (ob ^ (((ob >> 9) & 1) << 5)); }
__host__ __device__ __forceinline__ void stage_rc(int b, int& R, int& C) { const int st = b / 1024, sb = b % 1024, swz = sb ^ (((sb >> 9) & 1) << 5); R = (st >> 1) * 16 + swz / 64; C = (st & 1) * 32 + (swz % 64) / 2; }
__host__ __device__ __forceinline__ int perm32(int rho) { const int n = rho >> 4, i = rho & 15; return 8 * (i >> 2) + 4 * n + (i & 3); }

struct Unit { int pm, pn, ks; };
struct Gemm { const bf16_t* A; const bf16_t* Bt; int M, N, K, ld; };

struct StaticOrder {
    int nM, nN, nwg, G, c, S;
    __host__ __device__ void init(int M, int N, int G_, int c_, int S_) { nM = M / BM; nN = N / BM; nwg = nM * nN; G = G_; c = c_; S = S_; }
    __host__ __device__ bool next(int i, Unit& u) const {
        const long L = (long)i * G + c; if (L >= (long)nwg * S) return false;
        if (S > 1) { const int t = (int)L / S; u.ks = (int)L % S; u.pm = t / nN; u.pn = t % nN; return true; }
        u.ks = 0;
        int wgid = (int)L; { const int q = nwg / NXCD, r = nwg % NXCD, xcd = wgid % NXCD, off = wgid / NXCD; wgid = (xcd < r ? xcd * (q + 1) : r * (q + 1) + (xcd - r) * q) + off; }
        const int nig = WGM * nN, gid = wgid / nig, fm = gid * WGM, gsz = (nM - fm) < WGM ? (nM - fm) : WGM;
        u.pm = fm + ((wgid % nig) % gsz); u.pn = (wgid % nig) / gsz; return true;
    }
    __device__ __forceinline__ void a_ready(const Unit&) const {}
    __device__ __forceinline__ void done(const Unit&) const {}
};

__device__ __forceinline__ unsigned cvt_pk_bf16(float lo, float hi) { unsigned r; asm("v_cvt_pk_bf16_f32 %0, %1, %2" : "=v"(r) : "v"(lo), "v"(hi)); return r; }
template <int ACT> struct EpiStore {
    static constexpr bool PERM = true, AFTER_DRAIN = false;
    bf16_t* O; int ldc; size_t slab;
    __device__ __forceinline__ void operator()(const f32x4 (&acc)[2][2][4][2], const Unit& u, int wr, int wc, int fr, int fq) const {
        const int row0 = u.pm * BM + wr * 64 + fr; const int col0 = u.pn * BM + wc * 32 + 8 * fq;
#pragma unroll
        for (int ai = 0; ai < 2; ++ai)
#pragma unroll
            for (int m = 0; m < 4; ++m) { bf16_t* rowp = O + (size_t)u.ks * slab + (size_t)(row0 + ai * HALF + m * 16) * ldc + col0;
#pragma unroll
                for (int bj = 0; bj < 2; ++bj) { f32x4 v0 = acc[ai][bj][m][0], v1 = acc[ai][bj][m][1];
                    if (ACT == 2) {
#pragma unroll
                        for (int j = 0; j < 4; ++j) { float a = v0[j] > 0.f ? v0[j] : 0.f; v0[j] = a * a; float b = v1[j] > 0.f ? v1[j] : 0.f; v1[j] = b * b; } }
                    u32x4 w; w.x = cvt_pk_bf16(v0[0], v0[1]); w.y = cvt_pk_bf16(v0[2], v0[3]); w.z = cvt_pk_bf16(v1[0], v1[1]); w.w = cvt_pk_bf16(v1[2], v1[3]);
                    *(u32x4*)(rowp + bj * HALF) = w; } }
    }
    __device__ __forceinline__ void fused(f32x4 (&)[2][2][4][2], const Unit&, int, int, int, int, PG8_LAS unsigned char*, int, int) const {}
};
template <class Epi, class Sched, bool ALIGN_EPI = false, bool SP2 = false>
__device__ __forceinline__ void gemm_phase(PG8_LAS unsigned char* lds, const Gemm g, const Sched& S, const Epi& E) {
    int tid = threadIdx.x; asm volatile("" : "+v"(tid)); const int wid = __builtin_amdgcn_readfirstlane(tid >> 6), lane = tid & 63, wr = wid >> 2, wc = wid & 3, fr = lane & 15, fq = lane >> 4;
    const int K = g.K, nt = K / BK;
    unsigned voffA[2], voffB[2];
#pragma unroll
    for (int i = 0; i < 2; ++i) { int R, C; stage_rc(tid * 16 + i * 8192, R, C); const int Rb = Epi::PERM ? ((R & ~31) + perm32(R & 31)) : R;
        voffA[i] = (unsigned)(R * g.ld + C) * 2u; voffB[i] = (unsigned)(Rb * g.ld + C) * 2u; }
    const size_t kstep = (size_t)(BK * 2);
    const size_t hstep = (size_t)HALF * g.ld * 2; const size_t sstep = (size_t)K * 2;
    const size_t tstep = 2 * hstep;
    const unsigned ldsw = (unsigned)wid * 1024u;
    const int aoff = lds_byte(wr * 64 + fr, fq * 8), boff = lds_byte(wc * 32 + fr, fq * 8);
#define PG8_SA(b, h) (((b) * 2 + (h)) * HTB)
#define PG8_SB(b, h) ((4 + (b) * 2 + (h)) * HTB)
#define PG8_STAGE(bufoff, gbase, voff) do { _Pragma("unroll") for (int _i = 0; _i < 2; ++_i) \
        __builtin_amdgcn_global_load_lds((const unsigned*)((const char*)(gbase) + (voff)[_i]), (PG8_LAS unsigned*)(lds + (bufoff) + ldsw + _i * 8192), 16, 0, 0); } while (0)
#define PG8_LDA(dst, b, h) do { _Pragma("unroll") for (int m = 0; m < 4; ++m) _Pragma("unroll") for (int k = 0; k < 2; ++k) dst[m][k] = *(const PG8_LAS bf16x8*)(lds + PG8_SA(b, h) + aoff + m * 2048 + k * 1024); } while (0)
#define PG8_LDB(dst, b, h) do { _Pragma("unroll") for (int n = 0; n < 2; ++n) _Pragma("unroll") for (int k = 0; k < 2; ++k) dst[n][k] = *(const PG8_LAS bf16x8*)(lds + PG8_SB(b, h) + boff + n * 2048 + k * 1024); } while (0)
#define PG8_MMA(ai, bj, At, Bt) do { __builtin_amdgcn_s_setprio(1); _Pragma("unroll") for (int m = 0; m < 4; ++m) _Pragma("unroll") for (int n = 0; n < 2; ++n) _Pragma("unroll") for (int k = 0; k < 2; ++k) \
        acc[ai][bj][m][n] = __builtin_amdgcn_mfma_f32_16x16x32_bf16(Bt[n][k], At[m][k], acc[ai][bj][m][n], 0, 0, 0); __builtin_amdgcn_s_setprio(0); } while (0)
#define PG8_WAIT_V(n) asm volatile("s_waitcnt vmcnt(" #n ")" ::: "memory")
#define PG8_WAIT_L(n) asm volatile("s_waitcnt lgkmcnt(" #n ")" ::: "memory")
#define PG8_BAR __builtin_amdgcn_s_barrier()
#define PG8_SCHED __builtin_amdgcn_sched_barrier(0)
    Unit cur, nxt; int ui = 0;
    if (!S.next(0, cur)) return;
    f32x4 acc[2][2][4][2];
#pragma unroll
    for (int a = 0; a < 2; ++a)
#pragma unroll
        for (int b = 0; b < 2; ++b)
#pragma unroll
            for (int m = 0; m < 4; ++m)
#pragma unroll
                for (int n = 0; n < 2; ++n) acc[a][b][m][n] = (f32x4){0.f, 0.f, 0.f, 0.f};
    bf16x8 At[4][2], B0[2][2], B1[2][2];
    const char* cA = (const char*)g.A + (size_t)cur.pm * tstep + (size_t)cur.ks * sstep; const char* cB = (const char*)g.Bt + (size_t)cur.pn * tstep + (size_t)cur.ks * sstep;
    S.a_ready(cur);
    if constexpr (SP2) {
        PG8_STAGE(PG8_SB(0, 0), cB, voffB); PG8_STAGE(PG8_SB(0, 1), cB + hstep, voffB); PG8_STAGE(PG8_SA(0, 0), cA, voffA); PG8_STAGE(PG8_SA(0, 1), cA + hstep, voffA);
        if (wr == 1) PG8_BAR;
        PG8_WAIT_V(2); PG8_BAR;
        PG8_STAGE(PG8_SB(1, 0), cB + kstep, voffB); PG8_STAGE(PG8_SA(1, 0), cA + kstep, voffA); PG8_STAGE(PG8_SB(1, 1), cB + hstep + kstep, voffB);
        PG8_WAIT_V(6); PG8_BAR;
    } else {
        PG8_STAGE(PG8_SB(0, 0), cB, voffB); PG8_STAGE(PG8_SA(0, 0), cA, voffA); PG8_STAGE(PG8_SB(0, 1), cB + hstep, voffB); PG8_STAGE(PG8_SA(0, 1), cA + hstep, voffA);
        if (wr == 1) PG8_BAR;
        PG8_WAIT_V(4); PG8_BAR;
        PG8_STAGE(PG8_SB(1, 0), cB + kstep, voffB); PG8_STAGE(PG8_SA(1, 0), cA + kstep, voffA); PG8_STAGE(PG8_SB(1, 1), cB + hstep + kstep, voffB);
        PG8_WAIT_V(6); PG8_BAR;
    }
    for (;;) {
        const bool has_next = S.next(ui + 1, nxt);
        const char* nA = has_next ? (const char*)g.A + (size_t)nxt.pm * tstep + (size_t)nxt.ks * sstep : cA; const char* nB = has_next ? (const char*)g.Bt + (size_t)nxt.pn * tstep + (size_t)nxt.ks * sstep : cB;
        for (int t = 0; t < nt; t += 2) {
            const bool last = (t == nt - 2);
            const char* a1 = cA + (size_t)(t + 1) * kstep;
            const char* a2 = last ? nA : cA + (size_t)(t + 2) * kstep; const char* b2 = last ? nB : cB + (size_t)(t + 2) * kstep;
            const char* a3 = a2 + kstep; const char* b3 = b2 + kstep;
            if (last && has_next) S.a_ready(nxt);
            if constexpr (SP2) {
            PG8_LDB(B0, 0, 0); PG8_LDB(B1, 0, 1); PG8_SCHED; PG8_LDA(At, 0, 0); PG8_STAGE(PG8_SA(1, 1), a1 + hstep, voffA);
            PG8_WAIT_V(8); PG8_WAIT_L(0); PG8_BAR; PG8_MMA(0, 0, At, B0); PG8_MMA(0, 1, At, B1); PG8_BAR; PG8_SCHED;
            PG8_LDA(At, 0, 1); PG8_STAGE(PG8_SB(0, 0), b2, voffB); PG8_STAGE(PG8_SB(0, 1), b2 + hstep, voffB); PG8_STAGE(PG8_SA(0, 0), a2, voffA);
            PG8_WAIT_V(8); PG8_WAIT_L(0); PG8_BAR; PG8_MMA(1, 0, At, B0); PG8_MMA(1, 1, At, B1); PG8_BAR; PG8_SCHED;
            PG8_LDB(B0, 1, 0); PG8_LDB(B1, 1, 1); PG8_SCHED; PG8_LDA(At, 1, 0); PG8_STAGE(PG8_SA(0, 1), a2 + hstep, voffA);
            PG8_WAIT_V(8); PG8_WAIT_L(0); PG8_BAR; PG8_MMA(0, 0, At, B0); PG8_MMA(0, 1, At, B1); PG8_BAR; PG8_SCHED;
            PG8_LDA(At, 1, 1); PG8_STAGE(PG8_SB(1, 0), b3, voffB); PG8_STAGE(PG8_SB(1, 1), b3 + hstep, voffB); PG8_STAGE(PG8_SA(1, 0), a3, voffA);
            PG8_WAIT_V(8); PG8_WAIT_L(0); PG8_BAR; PG8_MMA(1, 0, At, B0); PG8_MMA(1, 1, At, B1); PG8_BAR; PG8_SCHED;
            } else {
            PG8_LDB(B0, 0, 0); PG8_SCHED; PG8_LDA(At, 0, 0); PG8_STAGE(PG8_SA(1, 1), a1 + hstep, voffA);
            PG8_WAIT_L(8); PG8_BAR; PG8_WAIT_L(0); PG8_MMA(0, 0, At, B0); PG8_BAR; PG8_SCHED;
            PG8_LDB(B1, 0, 1); PG8_STAGE(PG8_SB(0, 0), b2, voffB);
            PG8_BAR; PG8_WAIT_L(0); PG8_MMA(0, 1, At, B1); PG8_BAR;
            PG8_LDA(At, 0, 1); PG8_STAGE(PG8_SA(0, 0), a2, voffA);
            PG8_BAR; PG8_WAIT_L(0); PG8_MMA(1, 0, At, B0); PG8_BAR; PG8_SCHED;
            PG8_STAGE(PG8_SB(0, 1), b2 + hstep, voffB);
            PG8_WAIT_V(6); PG8_BAR; PG8_MMA(1, 1, At, B1); PG8_BAR;
            PG8_LDB(B0, 1, 0); PG8_SCHED; PG8_LDA(At, 1, 0); PG8_STAGE(PG8_SA(0, 1), a2 + hstep, voffA);
            PG8_WAIT_L(8); PG8_BAR; PG8_WAIT_L(0); PG8_MMA(0, 0, At, B0); PG8_BAR; PG8_SCHED;
            PG8_LDB(B1, 1, 1); PG8_STAGE(PG8_SB(1, 0), b3, voffB);
            PG8_BAR; PG8_WAIT_L(0); PG8_MMA(0, 1, At, B1); PG8_BAR;
            PG8_LDA(At, 1, 1); PG8_STAGE(PG8_SA(1, 0), a3, voffA);
            PG8_BAR; PG8_WAIT_L(0); PG8_MMA(1, 0, At, B0); PG8_BAR; PG8_SCHED;
            PG8_STAGE(PG8_SB(1, 1), b3 + hstep, voffB);
            PG8_WAIT_V(6); PG8_BAR; PG8_MMA(1, 1, At, B1); PG8_BAR;
            }
        }
        if constexpr (ALIGN_EPI) { if (wr == 0) PG8_BAR; }
        if constexpr (!Epi::AFTER_DRAIN) { E(acc, cur, wr, wc, fr, fq); S.done(cur); }
        if (!has_next) break;
#pragma unroll
        for (int a = 0; a < 2; ++a)
#pragma unroll
            for (int b = 0; b < 2; ++b)
#pragma unroll
                for (int m = 0; m < 4; ++m)
#pragma unroll
                    for (int n = 0; n < 2; ++n) acc[a][b][m][n] = (f32x4){0.f, 0.f, 0.f, 0.f};
        cur = nxt; cA = nA; cB = nB; ++ui;
        if constexpr (ALIGN_EPI) { if (wr == 1) PG8_BAR; }
    }
    PG8_WAIT_V(0);
    if constexpr (!ALIGN_EPI) { if (wr == 0) PG8_BAR; }
    PG8_BAR;
    if constexpr (Epi::AFTER_DRAIN) { E.fused(acc, cur, wr, wc, fr, fq, lds, wid, lane); S.done(cur); }
#undef PG8_SA
#undef PG8_SB
#undef PG8_STAGE
#undef PG8_LDA
#undef PG8_LDB
#undef PG8_MMA
#undef PG8_WAIT_V
#undef PG8_WAIT_L
#undef PG8_BAR
#undef PG8_SCHED
}
}

#define LAS __attribute__((address_space(3)))
typedef unsigned short bf16_t;
typedef short bf16x8 __attribute__((ext_vector_type(8)));
typedef float f32x4 __attribute__((ext_vector_type(4)));
typedef float f32x16 __attribute__((ext_vector_type(16)));
typedef unsigned u32x4 __attribute__((ext_vector_type(4)));
typedef unsigned u32x2 __attribute__((ext_vector_type(2)));

constexpr int DM = 1024, NBATCH = 16, SEQ = 2048, CTXL = 256, NLAYER = 2, DFF = 4096, INW = 2048;
constexpr int ML = NBATCH * SEQ, MC = NBATCH * CTXL, MT = ML + MC;
constexpr int NCHUNK = 36, KVLEN = CTXL + SEQ;
constexpr float EPS = 1e-6f, LOG2E = 1.4426950408889634f, QSCALE = 0.125f * 1.4426950408889634f;
constexpr int PH_PER_LAYER = 9;
constexpr int NPHASE = 2 + PH_PER_LAYER * NLAYER;
constexpr int LDS_BYTES = 131072 + 1024;
constexpr int MISC_OFF = 131072 + 256;
constexpr size_t CTL_ZERO_BYTES = 65536; constexpr int CW_BAR = 4096;

constexpr size_t MiB = 1u << 20;
constexpr size_t WS_CTL = 0, WS_MOD = 1 * MiB, WS_ROPE = 2 * MiB, WS_LRUW = 3 * MiB, WS_WIN = 4 * MiB, WS_WOUT = 12 * MiB, WS_W1 = 16 * MiB, WS_W2 = 32 * MiB,
                 WS_XC = 48 * MiB, WS_VT = 64 * MiB, WS_SUM = 82 * MiB, WS_H = 88 * MiB, WS_Z = 160 * MiB, WS_FEAT = 304 * MiB, WS_Y = 376 * MiB, WS_HID = 160 * MiB, WS_CARRY = 448 * MiB  , WS_AU0 = 88 * MiB  , WS_AU1 = 376 * MiB  , WS_SLAB = 448 * MiB, WS_XB1 = 448 * MiB  , WS_END = 512 * MiB;

enum { I_X = 0, I_C, I_CTX, I_CCTX, I_WMOD, I_BMOD, I_GPREMIX, I_GPOSTMIX, I_GPREMLP, I_GPOSTMLP, I_WIN, I_GQA, I_GKA, I_SINK, I_CONVW, I_CONVB, I_LWA, I_LBA, I_LWI, I_LBI, I_LLAM, I_WOUT, I_W1, I_W2, N_IN };
struct Args { const float* in[N_IN]; float* out; unsigned char* ws; int ph_lo, ph_hi; };

__device__ __forceinline__ unsigned cvt_pk(float lo, float hi) { unsigned r; asm("v_cvt_pk_bf16_f32 %0, %1, %2" : "=v"(r) : "v"(lo), "v"(hi)); return r; }
__device__ __forceinline__ float bf_lo(unsigned w) { return __uint_as_float(w << 16); }
__device__ __forceinline__ float bf_hi(unsigned w) { return __uint_as_float(w & 0xffff0000u); }
__device__ __forceinline__ void unpack8(const u32x4 w, float* v) { v[0] = bf_lo(w.x); v[1] = bf_hi(w.x); v[2] = bf_lo(w.y); v[3] = bf_hi(w.y); v[4] = bf_lo(w.z); v[5] = bf_hi(w.z); v[6] = bf_lo(w.w); v[7] = bf_hi(w.w); }
__device__ __forceinline__ u32x4 pack8(const float* v) { u32x4 w; w.x = cvt_pk(v[0], v[1]); w.y = cvt_pk(v[2], v[3]); w.z = cvt_pk(v[4], v[5]); w.w = cvt_pk(v[6], v[7]); return w; }
__device__ __forceinline__ float wave_sum(float v) {
#pragma unroll
    for (int o = 1; o < 64; o <<= 1) v += __shfl_xor(v, o);
    return v;
}
#define LDS_FENCE() asm volatile("s_waitcnt lgkmcnt(0)" ::: "memory")

__device__ __forceinline__ void transpose_item(const float* W, int K, int N, bf16_t* WT, float* scr, int item, int lane) {
    const int nblk = N / 32, kb = item / nblk, nb = item % nblk, k0 = 64 * kb, n0 = 32 * nb;
#pragma unroll 8
    for (int i = 0; i < 32; ++i) { const int kk = 2 * i + (lane >> 5); scr[kk * 33 + (lane & 31)] = W[(size_t)(k0 + kk) * N + n0 + (lane & 31)]; }
    LDS_FENCE();
    const int c = lane & 7;
#pragma unroll
    for (int j = 0; j < 4; ++j) { const int n = (lane >> 3) + 8 * j; const float* s = scr + (8 * c) * 33 + n;
        u32x4 o; o.x = cvt_pk(s[0 * 33], s[1 * 33]); o.y = cvt_pk(s[2 * 33], s[3 * 33]); o.z = cvt_pk(s[4 * 33], s[5 * 33]); o.w = cvt_pk(s[6 * 33], s[7 * 33]);
        *(u32x4*)(WT + (size_t)(n0 + n) * K + k0 + 8 * c) = o; }
    LDS_FENCE();
}

__device__ __forceinline__ void prologue_a(const Args& a, unsigned char* lds, int tid, int lane, int wave, int G) {
    float* scr = (float*)(lds + wave * 16384);
    const int gw = blockIdx.x * 8 + wave, NGW = G * 8;
    constexpr int I_IN = 16 * 64, I_OUT = 16 * 32, I_1 = 16 * 128, I_2 = 64 * 32, I_L = 64, NPER = I_IN + I_OUT + I_1 + I_2 + I_L;
    for (int it = gw; it < NLAYER * NPER; it += NGW) {
        const int l = it / NPER; int r = it - l * NPER;
        if (r < I_IN) { transpose_item(a.in[I_WIN] + (size_t)l * DM * INW, DM, INW, (bf16_t*)(a.ws + WS_WIN) + (size_t)l * INW * DM, scr, r, lane); continue; } r -= I_IN;
        if (r < I_OUT) { transpose_item(a.in[I_WOUT] + (size_t)l * DM * DM, DM, DM, (bf16_t*)(a.ws + WS_WOUT) + (size_t)l * DM * DM, scr, r, lane); continue; } r -= I_OUT;
        if (r < I_1) { transpose_item(a.in[I_W1] + (size_t)l * DM * DFF, DM, DFF, (bf16_t*)(a.ws + WS_W1) + (size_t)l * DFF * DM, scr, r, lane); continue; } r -= I_1;
        if (r < I_2) { transpose_item(a.in[I_W2] + (size_t)l * DFF * DM, DFF, DM, (bf16_t*)(a.ws + WS_W2) + (size_t)l * DM * DFF, scr, r, lane); continue; } r -= I_2;
        { const int mat = r >> 1, sub = r & 1, dir = mat >> 4, gate = (mat >> 3) & 1, h = mat & 7;
          const float* src = (gate ? a.in[I_LWI] : a.in[I_LWA]) + (size_t)(((l * 2 + dir) * 8 + h)) * 4096;
          bf16_t* dst = (bf16_t*)(a.ws + WS_LRUW) + (size_t)((((l * 2 + dir) * 2 + gate) * 8 + h)) * 4096;
          transpose_item(src, 64, 64, dst, scr, sub, lane); }
    }
    { const int gt = blockIdx.x * 512 + tid;
      if (gt < 96 * 16) { const int p = gt >> 4, i = gt & 15; const float inv = exp2f(-(float)i * 0.83048202372184058f); const float pos = (float)(p < 32 ? p : p - 32); const float ang = pos * inv;
          float* R = (float*)(a.ws + WS_ROPE); R[gt * 2] = __cosf(ang); R[gt * 2 + 1] = __sinf(ang); } }
    __syncthreads();
    if (blockIdx.x < 192) {
        float* act = (float*)lds; float* part = act + 17 * 1024; float* MOD = (float*)(a.ws + WS_MOD);
        for (int i = tid; i < 17 * 1024; i += 512) { const int r = i >> 10, k = i & 1023; const float c = r < 16 ? a.in[I_C][r * 1024 + k] : a.in[I_CCTX][k]; act[i] = c / (1.f + __expf(-c)); }
        __syncthreads();
        for (int bi = blockIdx.x; bi < 192; bi += G) {
            const int l = bi / 96, cb = bi % 96; const int n = cb * 64 + lane;
            const float* W = a.in[I_WMOD] + (size_t)l * DM * 6144 + n;
            float acc[17];
#pragma unroll
            for (int r = 0; r < 17; ++r) acc[r] = 0.f;
            const int k0 = wave * 128;
#pragma unroll 2
            for (int k = k0; k < k0 + 128; k += 4) {
                const float w0 = W[(size_t)k * 6144], w1 = W[(size_t)(k + 1) * 6144], w2 = W[(size_t)(k + 2) * 6144], w3 = W[(size_t)(k + 3) * 6144];
#pragma unroll
                for (int r = 0; r < 17; ++r) { const f32x4 av = *(const f32x4*)(act + r * 1024 + k); acc[r] += av.x * w0 + av.y * w1 + av.z * w2 + av.w * w3; }
            }
#pragma unroll
            for (int r = 0; r < 17; ++r) part[(wave * 17 + r) * 64 + lane] = acc[r];
            __syncthreads();
            for (int i = tid; i < 17 * 64; i += 512) { const int r = i >> 6, j = i & 63; float s = 0.f;
#pragma unroll
                for (int wv = 0; wv < 8; ++wv) s += part[(wv * 17 + r) * 64 + j];
                MOD[(size_t)(l * 17 + r) * 6144 + cb * 64 + j] = s + a.in[I_BMOD][l * 6144 + cb * 64 + j]; }
            __syncthreads();
        }
    }
}

struct RowArgs { const float* xin; const bf16_t* xinb; float* xout; bf16_t* xoutb; const bf16_t* y; int nslab; const float *gate, *gpost, *gpre, *sh, *sc; bf16_t* hout; };
struct RowIn { f32x4 x[4]; u32x4 xb[2]; u32x4 y[2]; };
__device__ __forceinline__ RowIn rp_load(int lane, const RowArgs& r) {
    RowIn in;
#pragma unroll
    for (int j = 0; j < 2; ++j) { const int c0 = 8 * lane + 512 * j;
        if (r.xinb) { in.xb[j] = *(const u32x4*)(r.xinb + c0); in.x[2 * j] = (f32x4){0.f, 0.f, 0.f, 0.f}; in.x[2 * j + 1] = in.x[2 * j]; }
        else { in.x[2 * j] = *(const f32x4*)(r.xin + c0); in.x[2 * j + 1] = *(const f32x4*)(r.xin + c0 + 4); in.xb[j] = (u32x4){0u, 0u, 0u, 0u}; } }
    if (r.y) {
#pragma unroll
        for (int j = 0; j < 2; ++j) in.y[j] = *(const u32x4*)(r.y + 8 * lane + 512 * j); }
    else { in.y[0] = (u32x4){0u, 0u, 0u, 0u}; in.y[1] = in.y[0]; }
    return in;
}
__device__ __forceinline__ void rp_compute(int lane, const RowArgs& r, const RowIn& in) {
    const size_t slab = (size_t)MC * DM;
    float xv[16];
#pragma unroll
    for (int j = 0; j < 4; ++j) { xv[4 * j] = in.x[j].x; xv[4 * j + 1] = in.x[j].y; xv[4 * j + 2] = in.x[j].z; xv[4 * j + 3] = in.x[j].w; }
    if (r.xinb) { unpack8(in.xb[0], xv); unpack8(in.xb[1], xv + 8); }
    if (r.y) {
        float yv[16]; float ss = 0.f;
#pragma unroll
        for (int j = 0; j < 2; ++j) unpack8(in.y[j], yv + 8 * j);
        for (int sl = 1; sl < r.nslab; ++sl) {
#pragma unroll
            for (int j = 0; j < 2; ++j) { float t8[8]; unpack8(*(const u32x4*)(r.y + (size_t)sl * slab + 8 * lane + 512 * j), t8);
#pragma unroll
                for (int e = 0; e < 8; ++e) yv[8 * j + e] += t8[e]; } }
#pragma unroll
        for (int e = 0; e < 16; ++e) ss += yv[e] * yv[e];
        ss = wave_sum(ss); const float rr = rsqrtf(ss * (1.f / DM) + EPS);
#pragma unroll
        for (int j = 0; j < 2; ++j) { const int c0 = 8 * lane + 512 * j;
#pragma unroll
            for (int e = 0; e < 8; ++e) xv[8 * j + e] += r.gate[c0 + e] * (yv[8 * j + e] * rr * r.gpost[c0 + e]);
            if (r.xoutb) *(u32x4*)(r.xoutb + c0) = pack8(xv + 8 * j);
            else { *(f32x4*)(r.xout + c0) = (f32x4){xv[8 * j], xv[8 * j + 1], xv[8 * j + 2], xv[8 * j + 3]}; *(f32x4*)(r.xout + c0 + 4) = (f32x4){xv[8 * j + 4], xv[8 * j + 5], xv[8 * j + 6], xv[8 * j + 7]}; } }
    }
    if (r.hout) {
        float ss = 0.f;
#pragma unroll
        for (int e = 0; e < 16; ++e) ss += xv[e] * xv[e];
        ss = wave_sum(ss); const float rr = rsqrtf(ss * (1.f / DM) + EPS);
#pragma unroll
        for (int j = 0; j < 2; ++j) { const int c0 = 8 * lane + 512 * j; float hv[8];
#pragma unroll
            for (int e = 0; e < 8; ++e) hv[e] = (xv[8 * j + e] * rr * r.gpre[c0 + e]) * (1.f + r.sc[c0 + e]) + r.sh[c0 + e];
            *(u32x4*)(r.hout + c0) = pack8(hv); }
    }
}
__device__ __forceinline__ RowArgs row_args(const Args& a, int kind, int l, int m) {
    RowArgs r; const bool lat = m < ML; const float* MOD = (const float*)(a.ws + WS_MOD);
    bf16_t* H = (bf16_t*)(a.ws + WS_H); const bf16_t* Y = (const bf16_t*)(a.ws + WS_Y); const bf16_t* SLAB = (const bf16_t*)(a.ws + WS_SLAB); float* XC = (float*)(a.ws + WS_XC);
    const int mrow = lat ? (m >> 11) : 16;
    const float* mod = MOD + (size_t)(l * 17 + mrow) * 6144;
    const size_t mc = lat ? 0 : (size_t)(m - ML);
    r.xinb = nullptr; r.xoutb = nullptr;
    if (kind == 0) { r.xin = lat ? a.in[I_X] + (size_t)m * DM : a.in[I_CTX] + mc * DM; r.xout = nullptr; r.y = nullptr; r.nslab = 0; r.gate = nullptr; r.gpost = nullptr;
        r.gpre = a.in[I_GPREMIX]; r.sh = mod; r.sc = mod + 1024; r.hout = H + (size_t)m * DM; return r; }
    const bool first = kind == 1, last = (!first && l == NLAYER - 1);
    bf16_t* xb0 = lat ? (bf16_t*)a.out + (size_t)m * DM : (bf16_t*)XC + mc * DM; bf16_t* xb1 = (bf16_t*)(a.ws + WS_XB1) + (size_t)m * DM;
    r.xin = nullptr; r.xout = nullptr;
    if (first && l == 0) { r.xin = lat ? a.in[I_X] + (size_t)m * DM : a.in[I_CTX] + mc * DM; r.xoutb = xb0; }
    else if (!first && l == 0) { r.xinb = xb0; r.xoutb = xb0; }
    else if (first) { r.xinb = xb0; r.xoutb = xb1; }
    else { r.xinb = xb1; r.xout = a.out + (size_t)m * DM; }
    r.nslab = lat ? 1 : 4;
    if (first) { r.y = lat ? Y + (size_t)m * DM : SLAB + mc * DM; r.gate = mod + 2048; r.gpost = a.in[I_GPOSTMIX] + l * DM; r.gpre = a.in[I_GPREMLP] + l * DM; r.sh = mod + 3072; r.sc = mod + 4096; r.hout = H + (size_t)m * DM; }
    else { const float* modn = MOD + (size_t)((last ? l : l + 1) * 17 + mrow) * 6144;
        r.y = lat ? H + (size_t)m * DM : SLAB + mc * DM; r.gate = mod + 5120; r.gpost = a.in[I_GPOSTMLP] + l * DM; r.gpre = last ? nullptr : a.in[I_GPREMIX] + (l + 1) * DM; r.sh = modn; r.sc = modn + 1024; r.hout = last ? nullptr : H + (size_t)m * DM; }
    return r;
}
__device__ __forceinline__ void phase_rows(const Args& a, int kind, int l, int Mrows, int lane, int gw, int NGW) {
    int m = gw; if (m >= Mrows) return;
    RowArgs ra = row_args(a, kind, l, m); RowIn cur = rp_load(lane, ra);
    for (;;) {
        const int mn = m + NGW; const bool hn = mn < Mrows;
        RowArgs rn = ra; RowIn nxt = cur;
        if (hn) { rn = row_args(a, kind, l, mn); nxt = rp_load(lane, rn); }
        rp_compute(lane, ra, cur);
        if (!hn) break;
        ra = rn; cur = nxt; m = mn;
    }
}

template <int DIR> __device__ __forceinline__ float dpp_prev(float v, int oldbits, int d) {
    const int iv = __builtin_bit_cast(int, v); int r;
    if (DIR == 0) { switch (d) { case 1: r = __builtin_amdgcn_update_dpp(oldbits, iv, 0x111, 0xf, 0xf, false); break; case 2: r = __builtin_amdgcn_update_dpp(oldbits, iv, 0x112, 0xf, 0xf, false); break;
                                  case 4: r = __builtin_amdgcn_update_dpp(oldbits, iv, 0x114, 0xf, 0xf, false); break; default: r = __builtin_amdgcn_update_dpp(oldbits, iv, 0x118, 0xf, 0xf, false); break; } }
    else           { switch (d) { case 1: r = __builtin_amdgcn_update_dpp(oldbits, iv, 0x101, 0xf, 0xf, false); break; case 2: r = __builtin_amdgcn_update_dpp(oldbits, iv, 0x102, 0xf, 0xf, false); break;
                                  case 4: r = __builtin_amdgcn_update_dpp(oldbits, iv, 0x104, 0xf, 0xf, false); break; default: r = __builtin_amdgcn_update_dpp(oldbits, iv, 0x108, 0xf, 0xf, false); break; } }
    return __builtin_bit_cast(float, r);
}

#define SCAN_STEP(SH, D) "v_fmac_f32_dpp %0, %0, %1 " SH ":" #D " row_mask:0xf bank_mask:0xf\n\tv_mul_f32_dpp %1, %1, %1 " SH ":" #D " row_mask:0xf bank_mask:0xf\n\ts_nop 1\n\t"
template <int DIR> __device__ __forceinline__ void scan16(float& a, float& u) {
    if (DIR == 0) asm volatile("s_nop 1\n\t" SCAN_STEP("row_shr", 1) SCAN_STEP("row_shr", 2) SCAN_STEP("row_shr", 4) SCAN_STEP("row_shr", 8) : "+v"(u), "+v"(a));
    else          asm volatile("s_nop 1\n\t" SCAN_STEP("row_shl", 1) SCAN_STEP("row_shl", 2) SCAN_STEP("row_shl", 4) SCAN_STEP("row_shl", 8) : "+v"(u), "+v"(a));
}
template <int DIR> __device__ __forceinline__ void scan16x8(float (&a)[2][4], float (&u)[2][4]) {
    if (DIR == 0) asm volatile("s_nop 1\n\tv_fmac_f32_dpp %0, %0, %8 row_shr:1 row_mask:0xf bank_mask:0xf\n\tv_fmac_f32_dpp %1, %1, %9 row_shr:1 row_mask:0xf bank_mask:0xf\n\tv_fmac_f32_dpp %2, %2, %10 row_shr:1 row_mask:0xf bank_mask:0xf\n\tv_fmac_f32_dpp %3, %3, %11 row_shr:1 row_mask:0xf bank_mask:0xf\n\tv_fmac_f32_dpp %4, %4, %12 row_shr:1 row_mask:0xf bank_mask:0xf\n\tv_fmac_f32_dpp %5, %5, %13 row_shr:1 row_mask:0xf bank_mask:0xf\n\tv_fmac_f32_dpp %6, %6, %14 row_shr:1 row_mask:0xf bank_mask:0xf\n\tv_fmac_f32_dpp %7, %7, %15 row_shr:1 row_mask:0xf bank_mask:0xf\n\tv_mul_f32_dpp %8, %8, %8 row_shr:1 row_mask:0xf bank_mask:0xf\n\tv_mul_f32_dpp %9, %9, %9 row_shr:1 row_mask:0xf bank_mask:0xf\n\tv_mul_f32_dpp %10, %10, %10 row_shr:1 row_mask:0xf bank_mask:0xf\n\tv_mul_f32_dpp %11, %11, %11 row_shr:1 row_mask:0xf bank_mask:0xf\n\tv_mul_f32_dpp %12, %12, %12 row_shr:1 row_mask:0xf bank_mask:0xf\n\tv_mul_f32_dpp %13, %13, %13 row_shr:1 row_mask:0xf bank_mask:0xf\n\tv_mul_f32_dpp %14, %14, %14 row_shr:1 row_mask:0xf bank_mask:0xf\n\tv_mul_f32_dpp %15, %15, %15 row_shr:1 row_mask:0xf bank_mask:0xf\n\tv_fmac_f32_dpp %0, %0, %8 row_shr:2 row_mask:0xf bank_mask:0xf\n\tv_fmac_f32_dpp %1, %1, %9 row_shr:2 row_mask:0xf bank_mask:0xf\n\tv_fmac_f32_dpp %2, %2, %10 row_shr:2 row_mask:0xf bank_mask:0xf\n\tv_fmac_f32_dpp %3, %3, %11 row_shr:2 row_mask:0xf bank_mask:0xf\n\tv_fmac_f32_dpp %4, %4, %12 row_shr:2 row_mask:0xf bank_mask:0xf\n\tv_fmac_f32_dpp %5, %5, %13 row_shr:2 row_mask:0xf bank_mask:0xf\n\tv_fmac_f32_dpp %6, %6, %14 row_shr:2 row_mask:0xf bank_mask:0xf\n\tv_fmac_f32_dpp %7, %7, %15 row_shr:2 row_mask:0xf bank_mask:0xf\n\tv_mul_f32_dpp %8, %8, %8 row_shr:2 row_mask:0xf bank_mask:0xf\n\tv_mul_f32_dpp %9, %9, %9 row_shr:2 row_mask:0xf bank_mask:0xf\n\tv_mul_f32_dpp %10, %10, %10 row_shr:2 row_mask:0xf bank_mask:0xf\n\tv_mul_f32_dpp %11, %11, %11 row_shr:2 row_mask:0xf bank_mask:0xf\n\tv_mul_f32_dpp %12, %12, %12 row_shr:2 row_mask:0xf bank_mask:0xf\n\tv_mul_f32_dpp %13, %13, %13 row_shr:2 row_mask:0xf bank_mask:0xf\n\tv_mul_f32_dpp %14, %14, %14 row_shr:2 row_mask:0xf bank_mask:0xf\n\tv_mul_f32_dpp %15, %15, %15 row_shr:2 row_mask:0xf bank_mask:0xf\n\tv_fmac_f32_dpp %0, %0, %8 row_shr:4 row_mask:0xf bank_mask:0xf\n\tv_fmac_f32_dpp %1, %1, %9 row_shr:4 row_mask:0xf bank_mask:0xf\n\tv_fmac_f32_dpp %2, %2, %10 row_shr:4 row_mask:0xf bank_mask:0xf\n\tv_fmac_f32_dpp %3, %3, %11 row_shr:4 row_mask:0xf bank_mask:0xf\n\tv_fmac_f32_dpp %4, %4, %12 row_shr:4 row_mask:0xf bank_mask:0xf\n\tv_fmac_f32_dpp %5, %5, %13 row_shr:4 row_mask:0xf bank_mask:0xf\n\tv_fmac_f32_dpp %6, %6, %14 row_shr:4 row_mask:0xf bank_mask:0xf\n\tv_fmac_f32_dpp %7, %7, %15 row_shr:4 row_mask:0xf bank_mask:0xf\n\tv_mul_f32_dpp %8, %8, %8 row_shr:4 row_mask:0xf bank_mask:0xf\n\tv_mul_f32_dpp %9, %9, %9 row_shr:4 row_mask:0xf bank_mask:0xf\n\tv_mul_f32_dpp %10, %10, %10 row_shr:4 row_mask:0xf bank_mask:0xf\n\tv_mul_f32_dpp %11, %11, %11 row_shr:4 row_mask:0xf bank_mask:0xf\n\tv_mul_f32_dpp %12, %12, %12 row_shr:4 row_mask:0xf bank_mask:0xf\n\tv_mul_f32_dpp %13, %13, %13 row_shr:4 row_mask:0xf bank_mask:0xf\n\tv_mul_f32_dpp %14, %14, %14 row_shr:4 row_mask:0xf bank_mask:0xf\n\tv_mul_f32_dpp %15, %15, %15 row_shr:4 row_mask:0xf bank_mask:0xf\n\tv_fmac_f32_dpp %0, %0, %8 row_shr:8 row_mask:0xf bank_mask:0xf\n\tv_fmac_f32_dpp %1, %1, %9 row_shr:8 row_mask:0xf bank_mask:0xf\n\tv_fmac_f32_dpp %2, %2, %10 row_shr:8 row_mask:0xf bank_mask:0xf\n\tv_fmac_f32_dpp %3, %3, %11 row_shr:8 row_mask:0xf bank_mask:0xf\n\tv_fmac_f32_dpp %4, %4, %12 row_shr:8 row_mask:0xf bank_mask:0xf\n\tv_fmac_f32_dpp %5, %5, %13 row_shr:8 row_mask:0xf bank_mask:0xf\n\tv_fmac_f32_dpp %6, %6, %14 row_shr:8 row_mask:0xf bank_mask:0xf\n\tv_fmac_f32_dpp %7, %7, %15 row_shr:8 row_mask:0xf bank_mask:0xf\n\tv_mul_f32_dpp %8, %8, %8 row_shr:8 row_mask:0xf bank_mask:0xf\n\tv_mul_f32_dpp %9, %9, %9 row_shr:8 row_mask:0xf bank_mask:0xf\n\tv_mul_f32_dpp %10, %10, %10 row_shr:8 row_mask:0xf bank_mask:0xf\n\tv_mul_f32_dpp %11, %11, %11 row_shr:8 row_mask:0xf bank_mask:0xf\n\tv_mul_f32_dpp %12, %12, %12 row_shr:8 row_mask:0xf bank_mask:0xf\n\tv_mul_f32_dpp %13, %13, %13 row_shr:8 row_mask:0xf bank_mask:0xf\n\tv_mul_f32_dpp %14, %14, %14 row_shr:8 row_mask:0xf bank_mask:0xf\n\tv_mul_f32_dpp %15, %15, %15 row_shr:8 row_mask:0xf bank_mask:0xf\n\ts_nop 1" : "+v"(u[0][0]), "+v"(u[0][1]), "+v"(u[0][2]), "+v"(u[0][3]), "+v"(u[1][0]), "+v"(u[1][1]), "+v"(u[1][2]), "+v"(u[1][3]), "+v"(a[0][0]), "+v"(a[0][1]), "+v"(a[0][2]), "+v"(a[0][3]), "+v"(a[1][0]), "+v"(a[1][1]), "+v"(a[1][2]), "+v"(a[1][3]));
    else          asm volatile("s_nop 1\n\tv_fmac_f32_dpp %0, %0, %8 row_shl:1 row_mask:0xf bank_mask:0xf\n\tv_fmac_f32_dpp %1, %1, %9 row_shl:1 row_mask:0xf bank_mask:0xf\n\tv_fmac_f32_dpp %2, %2, %10 row_shl:1 row_mask:0xf bank_mask:0xf\n\tv_fmac_f32_dpp %3, %3, %11 row_shl:1 row_mask:0xf bank_mask:0xf\n\tv_fmac_f32_dpp %4, %4, %12 row_shl:1 row_mask:0xf bank_mask:0xf\n\tv_fmac_f32_dpp %5, %5, %13 row_shl:1 row_mask:0xf bank_mask:0xf\n\tv_fmac_f32_dpp %6, %6, %14 row_shl:1 row_mask:0xf bank_mask:0xf\n\tv_fmac_f32_dpp %7, %7, %15 row_shl:1 row_mask:0xf bank_mask:0xf\n\tv_mul_f32_dpp %8, %8, %8 row_shl:1 row_mask:0xf bank_mask:0xf\n\tv_mul_f32_dpp %9, %9, %9 row_shl:1 row_mask:0xf bank_mask:0xf\n\tv_mul_f32_dpp %10, %10, %10 row_shl:1 row_mask:0xf bank_mask:0xf\n\tv_mul_f32_dpp %11, %11, %11 row_shl:1 row_mask:0xf bank_mask:0xf\n\tv_mul_f32_dpp %12, %12, %12 row_shl:1 row_mask:0xf bank_mask:0xf\n\tv_mul_f32_dpp %13, %13, %13 row_shl:1 row_mask:0xf bank_mask:0xf\n\tv_mul_f32_dpp %14, %14, %14 row_shl:1 row_mask:0xf bank_mask:0xf\n\tv_mul_f32_dpp %15, %15, %15 row_shl:1 row_mask:0xf bank_mask:0xf\n\tv_fmac_f32_dpp %0, %0, %8 row_shl:2 row_mask:0xf bank_mask:0xf\n\tv_fmac_f32_dpp %1, %1, %9 row_shl:2 row_mask:0xf bank_mask:0xf\n\tv_fmac_f32_dpp %2, %2, %10 row_shl:2 row_mask:0xf bank_mask:0xf\n\tv_fmac_f32_dpp %3, %3, %11 row_shl:2 row_mask:0xf bank_mask:0xf\n\tv_fmac_f32_dpp %4, %4, %12 row_shl:2 row_mask:0xf bank_mask:0xf\n\tv_fmac_f32_dpp %5, %5, %13 row_shl:2 row_mask:0xf bank_mask:0xf\n\tv_fmac_f32_dpp %6, %6, %14 row_shl:2 row_mask:0xf bank_mask:0xf\n\tv_fmac_f32_dpp %7, %7, %15 row_shl:2 row_mask:0xf bank_mask:0xf\n\tv_mul_f32_dpp %8, %8, %8 row_shl:2 row_mask:0xf bank_mask:0xf\n\tv_mul_f32_dpp %9, %9, %9 row_shl:2 row_mask:0xf bank_mask:0xf\n\tv_mul_f32_dpp %10, %10, %10 row_shl:2 row_mask:0xf bank_mask:0xf\n\tv_mul_f32_dpp %11, %11, %11 row_shl:2 row_mask:0xf bank_mask:0xf\n\tv_mul_f32_dpp %12, %12, %12 row_shl:2 row_mask:0xf bank_mask:0xf\n\tv_mul_f32_dpp %13, %13, %13 row_shl:2 row_mask:0xf bank_mask:0xf\n\tv_mul_f32_dpp %14, %14, %14 row_shl:2 row_mask:0xf bank_mask:0xf\n\tv_mul_f32_dpp %15, %15, %15 row_shl:2 row_mask:0xf bank_mask:0xf\n\tv_fmac_f32_dpp %0, %0, %8 row_shl:4 row_mask:0xf bank_mask:0xf\n\tv_fmac_f32_dpp %1, %1, %9 row_shl:4 row_mask:0xf bank_mask:0xf\n\tv_fmac_f32_dpp %2, %2, %10 row_shl:4 row_mask:0xf bank_mask:0xf\n\tv_fmac_f32_dpp %3, %3, %11 row_shl:4 row_mask:0xf bank_mask:0xf\n\tv_fmac_f32_dpp %4, %4, %12 row_shl:4 row_mask:0xf bank_mask:0xf\n\tv_fmac_f32_dpp %5, %5, %13 row_shl:4 row_mask:0xf bank_mask:0xf\n\tv_fmac_f32_dpp %6, %6, %14 row_shl:4 row_mask:0xf bank_mask:0xf\n\tv_fmac_f32_dpp %7, %7, %15 row_shl:4 row_mask:0xf bank_mask:0xf\n\tv_mul_f32_dpp %8, %8, %8 row_shl:4 row_mask:0xf bank_mask:0xf\n\tv_mul_f32_dpp %9, %9, %9 row_shl:4 row_mask:0xf bank_mask:0xf\n\tv_mul_f32_dpp %10, %10, %10 row_shl:4 row_mask:0xf bank_mask:0xf\n\tv_mul_f32_dpp %11, %11, %11 row_shl:4 row_mask:0xf bank_mask:0xf\n\tv_mul_f32_dpp %12, %12, %12 row_shl:4 row_mask:0xf bank_mask:0xf\n\tv_mul_f32_dpp %13, %13, %13 row_shl:4 row_mask:0xf bank_mask:0xf\n\tv_mul_f32_dpp %14, %14, %14 row_shl:4 row_mask:0xf bank_mask:0xf\n\tv_mul_f32_dpp %15, %15, %15 row_shl:4 row_mask:0xf bank_mask:0xf\n\tv_fmac_f32_dpp %0, %0, %8 row_shl:8 row_mask:0xf bank_mask:0xf\n\tv_fmac_f32_dpp %1, %1, %9 row_shl:8 row_mask:0xf bank_mask:0xf\n\tv_fmac_f32_dpp %2, %2, %10 row_shl:8 row_mask:0xf bank_mask:0xf\n\tv_fmac_f32_dpp %3, %3, %11 row_shl:8 row_mask:0xf bank_mask:0xf\n\tv_fmac_f32_dpp %4, %4, %12 row_shl:8 row_mask:0xf bank_mask:0xf\n\tv_fmac_f32_dpp %5, %5, %13 row_shl:8 row_mask:0xf bank_mask:0xf\n\tv_fmac_f32_dpp %6, %6, %14 row_shl:8 row_mask:0xf bank_mask:0xf\n\tv_fmac_f32_dpp %7, %7, %15 row_shl:8 row_mask:0xf bank_mask:0xf\n\tv_mul_f32_dpp %8, %8, %8 row_shl:8 row_mask:0xf bank_mask:0xf\n\tv_mul_f32_dpp %9, %9, %9 row_shl:8 row_mask:0xf bank_mask:0xf\n\tv_mul_f32_dpp %10, %10, %10 row_shl:8 row_mask:0xf bank_mask:0xf\n\tv_mul_f32_dpp %11, %11, %11 row_shl:8 row_mask:0xf bank_mask:0xf\n\tv_mul_f32_dpp %12, %12, %12 row_shl:8 row_mask:0xf bank_mask:0xf\n\tv_mul_f32_dpp %13, %13, %13 row_shl:8 row_mask:0xf bank_mask:0xf\n\tv_mul_f32_dpp %14, %14, %14 row_shl:8 row_mask:0xf bank_mask:0xf\n\tv_mul_f32_dpp %15, %15, %15 row_shl:8 row_mask:0xf bank_mask:0xf\n\ts_nop 1" : "+v"(u[0][0]), "+v"(u[0][1]), "+v"(u[0][2]), "+v"(u[0][3]), "+v"(u[1][0]), "+v"(u[1][1]), "+v"(u[1][2]), "+v"(u[1][3]), "+v"(a[0][0]), "+v"(a[0][1]), "+v"(a[0][2]), "+v"(a[0][3]), "+v"(a[1][0]), "+v"(a[1][1]), "+v"(a[1][2]), "+v"(a[1][3]));
}
struct LruCtx { const Args* a; int l, b, c, w; int lane, tok, q; float* xc; long rowbase; int t0; };

__device__ __forceinline__ void lru_conv(const LruCtx& L) {
    const Args& a = *L.a; const int ch = L.w * 64 + L.lane;
    const bool isctx = L.c < 4; const int seqlen = isctx ? CTXL : SEQ;
    const float* cw = a.in[I_CONVW] + (size_t)L.l * 4 * 512 + ch; const float w0 = cw[0], w1 = cw[512], w2 = cw[1024], w3 = cw[1536], cb = a.in[I_CONVB][L.l * 512 + ch];
    const bf16_t* zc = (const bf16_t*)(a.ws + WS_Z) + (size_t)L.rowbase * INW + 1024 + ch;
    float zz[67];
#pragma unroll
    for (int i = 0; i < 67; ++i) { const int t = L.t0 - 2 + i; const int tc = t < 0 ? 0 : (t >= seqlen ? seqlen - 1 : t); zz[i] = __uint_as_float((unsigned)zc[(size_t)tc * INW] << 16); }
    if (L.t0 == 0) { zz[0] = 0.f; zz[1] = 0.f; }
    if (L.t0 + 64 >= seqlen) zz[66] = 0.f;
#pragma unroll
    for (int i = 0; i < 64; ++i) L.xc[i * 64 + (L.lane ^ ((i & 15) << 2))] = cb + w0 * zz[i] + w1 * zz[i + 1] + w2 * zz[i + 2] + w3 * zz[i + 3];
    LDS_FENCE();
}

template <bool FINAL, int DIR> __device__ __forceinline__ void lru_pass(const LruCtx& L, int ntp, float (&hin)[2][4], float (&atot)[2][4], float (&hb)[4][2][4]) {
    const Args& a = *L.a;
    bf16x8 wa[2][2], wi[2][2]; f32x4 ba[2], bi[2]; float sp[2][4];
    if (!FINAL)
#pragma unroll
    for (int j = 0; j < 2; ++j) {
        const int nt = 2 * ntp + j, chb = L.w * 64 + 16 * nt + 4 * L.q;
        const bf16_t* Wa = (const bf16_t*)(a.ws + WS_LRUW) + (size_t)((((L.l * 2 + DIR) * 2 + 0) * 8 + L.w)) * 4096 + (16 * nt + L.tok) * 64 + 8 * L.q;
        const bf16_t* Wi = Wa + 8 * 4096;
#pragma unroll
        for (int ks = 0; ks < 2; ++ks) { wa[j][ks] = *(const bf16x8*)(Wa + 32 * ks); wi[j][ks] = *(const bf16x8*)(Wi + 32 * ks); }
        const int pofs = (L.l * 2 + DIR) * 512 + chb;
        ba[j] = *(const f32x4*)(a.in[I_LBA] + pofs); bi[j] = *(const f32x4*)(a.in[I_LBI] + pofs); const f32x4 lam = *(const f32x4*)(a.in[I_LLAM] + pofs);
#pragma unroll
        for (int r = 0; r < 4; ++r) { const float x = -lam[r]; const float spl = (x > 0.f ? x : 0.f) + __logf(1.f + __expf(-fabsf(x))); sp[j][r] = 8.f * spl * LOG2E; }
    }
    u32x4 auw[4][2];
    if (FINAL) {
        const unsigned* AUb = (const unsigned*)(a.ws + (DIR == 0 ? WS_AU0 : WS_AU1)) + (size_t)(L.rowbase + L.t0 + L.tok) * 512 + L.w * 64 + 32 * ntp + 4 * L.q;
#pragma unroll
        for (int T = 0; T < 4; ++T)
#pragma unroll
            for (int j = 0; j < 2; ++j) auw[T][j] = *(const u32x4*)(AUb + (size_t)(16 * T) * 512 + 16 * j);
        asm volatile("" : "+v"(auw[0][0]), "+v"(auw[0][1]), "+v"(auw[1][0]), "+v"(auw[1][1]), "+v"(auw[2][0]), "+v"(auw[2][1]), "+v"(auw[3][0]), "+v"(auw[3][1]));
    }
    u32x2 grw[4][2];
    if (FINAL && DIR == 0) {
        const bf16_t* GRb = (const bf16_t*)(a.ws + WS_Z) + (size_t)(L.rowbase + L.t0 + L.tok) * INW + 1536 + L.w * 64 + 32 * ntp + 4 * L.q;
#pragma unroll
        for (int T = 0; T < 4; ++T)
#pragma unroll
            for (int j = 0; j < 2; ++j) grw[T][j] = *(const u32x2*)(GRb + (size_t)(16 * T) * INW + 16 * j);
        asm volatile("" : "+v"(grw[0][0]), "+v"(grw[0][1]), "+v"(grw[1][0]), "+v"(grw[1][1]), "+v"(grw[2][0]), "+v"(grw[2][1]), "+v"(grw[3][0]), "+v"(grw[3][1]));
    }
#pragma unroll
    for (int Ti = 0; Ti < 4; ++Ti) {
        const int T = DIR == 0 ? Ti : 3 - Ti;
        float av[2][4], uv[2][4];
        const long trow = L.rowbase + L.t0 + 16 * T + L.tok;
        unsigned* AU = (unsigned*)(a.ws + (DIR == 0 ? WS_AU0 : WS_AU1)) + (size_t)trow * 512 + L.w * 64 + 32 * ntp + 4 * L.q;
        if (FINAL) {
#pragma unroll
            for (int j = 0; j < 2; ++j) { const u32x4 w = auw[T][j];
#pragma unroll
                for (int r = 0; r < 4; ++r) { av[j][r] = __builtin_amdgcn_exp2f(bf_lo(w[r])); uv[j][r] = bf_hi(w[r]); } }
        } else {
        const float* xrow = L.xc + (16 * T + L.tok) * 64; const int xsw = L.tok << 2;
        bf16x8 xb[2];
#pragma unroll
        for (int ks = 0; ks < 2; ++ks) { const f32x4 p = *(const f32x4*)(xrow + ((32 * ks + 8 * L.q) ^ xsw)), q = *(const f32x4*)(xrow + ((32 * ks + 8 * L.q + 4) ^ xsw));
            u32x4 w; w.x = cvt_pk(p.x, p.y); w.y = cvt_pk(p.z, p.w); w.z = cvt_pk(q.x, q.y); w.w = cvt_pk(q.z, q.w); xb[ks] = __builtin_bit_cast(bf16x8, w); }
#pragma unroll
        for (int j = 0; j < 2; ++j) {
            f32x4 aa = {0.f, 0.f, 0.f, 0.f}, ai = {0.f, 0.f, 0.f, 0.f};
            aa = __builtin_amdgcn_mfma_f32_16x16x32_bf16(wa[j][0], xb[0], aa, 0, 0, 0); aa = __builtin_amdgcn_mfma_f32_16x16x32_bf16(wa[j][1], xb[1], aa, 0, 0, 0);
            ai = __builtin_amdgcn_mfma_f32_16x16x32_bf16(wi[j][0], xb[0], ai, 0, 0, 0); ai = __builtin_amdgcn_mfma_f32_16x16x32_bf16(wi[j][1], xb[1], ai, 0, 0, 0);
            const f32x4 xo = *(const f32x4*)(xrow + ((16 * (2 * ntp + j) + 4 * L.q) ^ xsw));
            u32x4 pw;
#pragma unroll
            for (int r = 0; r < 4; ++r) {
                const float rg = __builtin_amdgcn_rcpf(1.f + __builtin_amdgcn_exp2f(-(aa[r] + ba[j][r]) * LOG2E));
                const float ig = __builtin_amdgcn_rcpf(1.f + __builtin_amdgcn_exp2f(-(ai[r] + bi[j][r]) * LOG2E));
                const float la = -rg * sp[j][r];
                const float a_ = __builtin_amdgcn_exp2f(la);
                float om = 1.f - a_ * a_; om = om > 0.f ? om : 0.f;
                av[j][r] = a_; uv[j][r] = __builtin_amdgcn_sqrtf(om) * (ig * xo[r]);
                pw[r] = cvt_pk(la, uv[j][r]);
            }
            *(u32x4*)(AU + 16 * j) = pw;
        }
        }
        scan16x8<DIR>(av, uv);
        float hv[2][4];
        const int src = (L.lane & 48) | (DIR == 0 ? 15 : 0);
#pragma unroll
        for (int j = 0; j < 2; ++j)
#pragma unroll
            for (int r = 0; r < 4; ++r) { const float h = av[j][r] * hin[j][r] + uv[j][r]; hv[j][r] = h; hin[j][r] = __shfl(h, src); if (!FINAL) atot[j][r] *= __shfl(av[j][r], src); }
        if (FINAL) {
            if (DIR == 1) {
#pragma unroll
                for (int j = 0; j < 2; ++j)
#pragma unroll
                    for (int r = 0; r < 4; ++r) hb[T][j][r] = hv[j][r];
            } else {
                const long row = L.rowbase + L.t0 + 16 * T + L.tok;
#pragma unroll
                for (int j = 0; j < 2; ++j) {
                    const int chb = L.w * 64 + 16 * (2 * ntp + j) + 4 * L.q;
                    const u32x2 gw = grw[T][j];
                    const float g[4] = {bf_lo(gw.x), bf_hi(gw.x), bf_lo(gw.y), bf_hi(gw.y)}; float o[4];
#pragma unroll
                    for (int r = 0; r < 4; ++r) { const float x = g[r]; const float ge = x * __builtin_amdgcn_rcpf(1.f + __builtin_amdgcn_exp2f(-2.f * 0.7978845608028654f * LOG2E * (x + 0.044715f * x * x * x))); o[r] = (hv[j][r] + hb[T][j][r]) * ge; }
                    u32x2 ow; ow.x = cvt_pk(o[0], o[1]); ow.y = cvt_pk(o[2], o[3]);
                    *(u32x2*)((bf16_t*)(a.ws + WS_FEAT) + (size_t)row * DM + 512 + chb) = ow;
                }
            }
        }
    }
}

__device__ __forceinline__ void lru_setup(LruCtx& L, const Args& a, int l, int it, int lane, float* xc) {
    L.a = &a; L.l = l; L.b = it / (NCHUNK * 8); const int rem = it - L.b * (NCHUNK * 8); L.c = rem >> 3; L.w = rem & 7; L.lane = lane; L.tok = lane & 15; L.q = lane >> 4; L.xc = xc;
    const bool isctx = L.c < 4; L.rowbase = isctx ? (long)ML + L.b * CTXL : (long)L.b * SEQ; L.t0 = isctx ? L.c * 64 : (L.c - 4) * 64;
}

__device__ __forceinline__ void lru_summary_item(const Args& a, int l, int it, int lane, float* xc) {
    LruCtx L; lru_setup(L, a, l, it, lane, xc);
    lru_conv(L);
    float* SUM = (float*)(a.ws + WS_SUM);
    float hb[4][2][4];
#pragma unroll 1
    for (int ntp = 0; ntp < 2; ++ntp) {
        { float hin[2][4] = {{0.f, 0.f, 0.f, 0.f}, {0.f, 0.f, 0.f, 0.f}}, at[2][4] = {{1.f, 1.f, 1.f, 1.f}, {1.f, 1.f, 1.f, 1.f}}; lru_pass<false, 0>(L, ntp, hin, at, hb);
          if (L.tok == 0) {
#pragma unroll
              for (int j = 0; j < 2; ++j) { float* p = SUM + (size_t)(((L.b * NCHUNK + L.c) * 2 + 0) * 2) * 512 + L.w * 64 + 16 * (2 * ntp + j) + 4 * L.q; *(f32x4*)p = (f32x4){at[j][0], at[j][1], at[j][2], at[j][3]}; *(f32x4*)(p + 512) = (f32x4){hin[j][0], hin[j][1], hin[j][2], hin[j][3]}; } } }
        { float hin[2][4] = {{0.f, 0.f, 0.f, 0.f}, {0.f, 0.f, 0.f, 0.f}}, at[2][4] = {{1.f, 1.f, 1.f, 1.f}, {1.f, 1.f, 1.f, 1.f}}; lru_pass<false, 1>(L, ntp, hin, at, hb);
          if (L.tok == 0) {
#pragma unroll
              for (int j = 0; j < 2; ++j) { float* p = SUM + (size_t)(((L.b * NCHUNK + L.c) * 2 + 1) * 2) * 512 + L.w * 64 + 16 * (2 * ntp + j) + 4 * L.q; *(f32x4*)p = (f32x4){at[j][0], at[j][1], at[j][2], at[j][3]}; *(f32x4*)(p + 512) = (f32x4){hin[j][0], hin[j][1], hin[j][2], hin[j][3]}; } } }
    }
    LDS_FENCE();
}

__device__ __forceinline__ void lru_fold(const float* SUM, int b, int j, int dir, int chb, float (&h)[4]) {
    const float* p = SUM + (size_t)(((b * NCHUNK + j) * 2 + dir) * 2) * 512 + chb; const f32x4 A = *(const f32x4*)p, H = *(const f32x4*)(p + 512);
#pragma unroll
    for (int r = 0; r < 4; ++r) h[r] = A[r] * h[r] + H[r];
}

__device__ __forceinline__ void lru_final_item(const Args& a, int l, int it, int lane, float* xc) {
    LruCtx L; lru_setup(L, a, l, it, lane, xc);
    float hb[4][2][4], at[2][4] = {{1.f, 1.f, 1.f, 1.f}, {1.f, 1.f, 1.f, 1.f}};
#pragma unroll 1
    for (int ntp = 0; ntp < 2; ++ntp) {
        float hf[2][4], hbk[2][4];
#pragma unroll
        for (int j = 0; j < 2; ++j) {
            const float* cp = (const float*)(a.ws + WS_CARRY) + (size_t)((L.b * NCHUNK + L.c) * 2) * 512 + L.w * 64 + 16 * (2 * ntp + j) + 4 * L.q;
            const f32x4 cf = *(const f32x4*)cp, cbk = *(const f32x4*)(cp + 512);
#pragma unroll
            for (int r = 0; r < 4; ++r) { hf[j][r] = cf[r]; hbk[j][r] = cbk[r]; }
        }
        lru_pass<true, 1>(L, ntp, hbk, at, hb);
        lru_pass<true, 0>(L, ntp, hf, at, hb);
    }
    LDS_FENCE();
}

__device__ __forceinline__ void phase_prep(const Args& a, int l, unsigned char* lds, int lane, int wave, int G) {
    const int gw = blockIdx.x * 8 + wave, NGW = G * 8;
    bf16_t* Z = (bf16_t*)(a.ws + WS_Z);
    for (int it = gw; it < NBATCH * NCHUNK * 8; it += NGW) lru_summary_item(a, l, it, lane, (float*)(lds + wave * 16384));
    const int nheavy = (NBATCH * NCHUNK * 8) % NGW; const bool rebal = nheavy > 0 && nheavy * 2 < NGW;
    const int gw2 = rebal ? gw - nheavy : gw, NGW2 = rebal ? NGW - nheavy : NGW;
    { bf16_t* tile = (bf16_t*)(lds + wave * 16384); bf16_t* VT = (bf16_t*)(a.ws + WS_VT);
      if (gw2 >= 0) for (int it0 = gw2; it0 < (MT / 64) * 4; it0 += NGW2) {
          const int it = it0; const int tt = it >> 2, which = it & 3; const int row0 = tt * 64; int b, pos0;
          if (row0 < ML) { b = row0 >> 11; pos0 = CTXL + (row0 & 2047); } else { const int r = row0 - ML; b = r >> 8; pos0 = r & 255; }
          const int col0 = which < 2 ? 384 + which * 64 : 896 + (which - 2) * 64;
          u32x4 wv[8];
#pragma unroll
          for (int i = 0; i < 8; ++i) { const int tok = i * 8 + (lane >> 3); wv[i] = *(const u32x4*)(Z + (size_t)(row0 + tok) * INW + col0 + 8 * (lane & 7)); }
          asm volatile("" : "+v"(wv[0]), "+v"(wv[1]), "+v"(wv[2]), "+v"(wv[3]), "+v"(wv[4]), "+v"(wv[5]), "+v"(wv[6]), "+v"(wv[7]));
#pragma unroll
          for (int i = 0; i < 8; ++i) { const int tok = i * 8 + (lane >> 3); *(u32x4*)(tile + tok * 72 + 8 * (lane & 7)) = wv[i]; }
          LDS_FENCE();
          bf16_t* dst = VT + (size_t)((b * 4 + which) * 64 + lane) * KVLEN + pos0;
#pragma unroll
          for (int g = 0; g < 8; ++g) { u32x4 o;
              o.x = (unsigned)tile[(8 * g + 0) * 72 + lane] | ((unsigned)tile[(8 * g + 1) * 72 + lane] << 16); o.y = (unsigned)tile[(8 * g + 2) * 72 + lane] | ((unsigned)tile[(8 * g + 3) * 72 + lane] << 16);
              o.z = (unsigned)tile[(8 * g + 4) * 72 + lane] | ((unsigned)tile[(8 * g + 5) * 72 + lane] << 16); o.w = (unsigned)tile[(8 * g + 6) * 72 + lane] | ((unsigned)tile[(8 * g + 7) * 72 + lane] << 16);
              *(u32x4*)(dst + 8 * g) = o; }
          LDS_FENCE();
      } }
    { const float* ROPE = (const float*)(a.ws + WS_ROPE); const int e8 = lane & 7;
      constexpr int NQK = MT * 12 / 8;
      u32x4 wnext = {0u, 0u, 0u, 0u};
      f32x4 gq[2], gk[2], rnext[4];
      gq[0] = *(const f32x4*)(a.in[I_GQA] + l * 64 + 8 * e8); gq[1] = *(const f32x4*)(a.in[I_GQA] + l * 64 + 8 * e8 + 4); gk[0] = *(const f32x4*)(a.in[I_GKA] + l * 64 + 8 * e8); gk[1] = *(const f32x4*)(a.in[I_GKA] + l * 64 + 8 * e8 + 4);
#pragma unroll
      for (int i = 0; i < 4; ++i) rnext[i] = (f32x4){1.f, 0.f, 1.f, 0.f};
#define QK_ROPE_LOAD(mm) do { const int t_ = (mm) & 2047; const int pp_ = e8 < 4 ? (t_ >> 6) : 32 + (t_ & 63); const float* tb_ = ROPE + (pp_ * 16 + 8 * (e8 & 1)) * 2; \
          _Pragma("unroll") for (int i = 0; i < 4; ++i) rnext[i] = *(const f32x4*)(tb_ + 4 * i); } while (0)
      if (gw2 >= 0 && gw2 < NQK) { const int idx0 = gw2 * 8 + (lane >> 3); const int m0 = idx0 / 12, hs0 = idx0 - m0 * 12;
          const int c00 = hs0 < 4 ? hs0 * 64 : hs0 < 6 ? 256 + (hs0 - 4) * 64 : hs0 < 10 ? 512 + (hs0 - 6) * 64 : 768 + (hs0 - 10) * 64; wnext = *(const u32x4*)(Z + (size_t)m0 * INW + c00 + 8 * e8); if (m0 < ML) QK_ROPE_LOAD(m0); }
      if (gw2 >= 0) for (int it = gw2; it < NQK; it += NGW2) {
          const int idx = it * 8 + (lane >> 3); const int m = idx / 12, hs = idx - m * 12;
          const int col0 = hs < 4 ? hs * 64 : hs < 6 ? 256 + (hs - 4) * 64 : hs < 10 ? 512 + (hs - 6) * 64 : 768 + (hs - 10) * 64;
          const bool lat = m < ML, isq = hs < 4 || (hs >= 6 && hs < 10), nrm = hs < 6;
          bf16_t* p = Z + (size_t)m * INW + col0 + 8 * e8;
          float v[8]; unpack8(wnext, v);
          const f32x4 rc0 = rnext[0], rc1 = rnext[1], rc2 = rnext[2], rc3 = rnext[3];
          if (it + NGW2 < NQK) { const int idx1 = (it + NGW2) * 8 + (lane >> 3); const int m1 = idx1 / 12, hs1 = idx1 - m1 * 12;
              const int c1 = hs1 < 4 ? hs1 * 64 : hs1 < 6 ? 256 + (hs1 - 4) * 64 : hs1 < 10 ? 512 + (hs1 - 6) * 64 : 768 + (hs1 - 10) * 64; wnext = *(const u32x4*)(Z + (size_t)m1 * INW + c1 + 8 * e8); if (m1 < ML) QK_ROPE_LOAD(m1); }
          if (nrm) { float ss = 0.f;
#pragma unroll
              for (int e = 0; e < 8; ++e) ss += v[e] * v[e];
              ss += __shfl_xor(ss, 1); ss += __shfl_xor(ss, 2); ss += __shfl_xor(ss, 4);
              const float r = rsqrtf(ss * (1.f / 64.f) + EPS); const f32x4 g0 = hs < 4 ? gq[0] : gk[0], g1 = hs < 4 ? gq[1] : gk[1];
#pragma unroll
              for (int e = 0; e < 4; ++e) { v[e] = v[e] * r * g0[e]; v[4 + e] = v[4 + e] * r * g1[e]; } }
          if (lat) { const float cs_[8] = {rc0[0], rc0[2], rc1[0], rc1[2], rc2[0], rc2[2], rc3[0], rc3[2]}, sn_[8] = {rc0[1], rc0[3], rc1[1], rc1[3], rc2[1], rc2[3], rc3[1], rc3[3]};
#pragma unroll
              for (int e = 0; e < 8; ++e) { const float pv = __shfl_xor(v[e], 2); v[e] = (e8 & 2) ? v[e] * cs_[e] + pv * sn_[e] : v[e] * cs_[e] - pv * sn_[e]; } }
          if (isq) {
#pragma unroll
              for (int e = 0; e < 8; ++e) v[e] *= QSCALE; }
          *(u32x4*)p = pack8(v);
      }
#undef QK_ROPE_LOAD
    }
}

__device__ __forceinline__ float fadd_s(float x, float y) { float r; asm("v_add_f32_e32 %0, %1, %2" : "=v"(r) : "v"(x), "v"(y)); return r; }
__device__ __forceinline__ int crow(int r, int hi) { return (r & 3) + 8 * (r >> 2) + 4 * hi; }
__device__ __forceinline__ void attn_unit(const Args& a, int l, int type, int b, int kvh, int qt, unsigned char* lds, int tid, int lane, int wid) {
    const bool isB = type & 1, isCtx = type >> 1;
    const int r32 = lane & 31, hi = lane >> 5, head = kvh * 2 + (wid >> 2);
    const int qpos = qt * 128 + (wid & 3) * 32 + r32;
    const long qrow = isCtx ? (long)ML + b * CTXL + qpos : (long)b * SEQ + qpos;
    const bf16_t* Z = (const bf16_t*)(a.ws + WS_Z);
    const int kcol = (isB ? 768 : 256) + kvh * 64;
    const bf16_t* vt = (const bf16_t*)(a.ws + WS_VT) + (size_t)((b * 4 + (isB ? 2 : 0) + kvh) * 64) * KVLEN;
    int lt_lo = 0, n_lat = 0;
    if (!isCtx) { if (!isB) { lt_lo = 0; n_lat = 32; } else { lt_lo = 2 * qt - 2 < 0 ? 0 : 2 * qt - 2; const int lt_hi = 2 * qt + 3 > 31 ? 31 : 2 * qt + 3; n_lat = lt_hi - lt_lo + 1; } }
    const int NT = 4 + n_lat;
    bf16x8 qr[4];
    { const bf16_t* qp = Z + (size_t)qrow * INW + (isB ? 512 : 0) + head * 64 + 8 * hi;
#pragma unroll
      for (int ks = 0; ks < 4; ++ks) qr[ks] = *(const bf16x8*)(qp + 16 * ks); }
    float m_run = 0.f, l_run = 0.f;
    if (isB) { m_run = a.in[I_SINK][l * 4 + head] * LOG2E; l_run = hi == 0 ? 1.f : 0.f; }
    f32x16 negm;
#pragma unroll
    for (int r = 0; r < 16; ++r) negm[r] = -m_run;
    f32x16 o[2];
#pragma unroll
    for (int r = 0; r < 16; ++r) { o[0][r] = 0.f; o[1][r] = 0.f; }
    const int srow = tid >> 3, sch = tid & 7;
    const int soff = srow * 144 + sch * 16;
    u32x4 kreg = {0u, 0u, 0u, 0u}, vreg = {0u, 0u, 0u, 0u};
#define ATT_KT(t) ((t) < 4 ? (t) : 4 + lt_lo + (t) - 4)
#define ATT_GK(t) do { const int kt_ = ATT_KT(t); const long krow_ = kt_ < 4 ? (long)ML + b * CTXL + kt_ * 64 + srow : (long)b * SEQ + (kt_ - 4) * 64 + srow; kreg = *(const u32x4*)(Z + (size_t)krow_ * INW + kcol + 8 * sch); } while (0)
#define ATT_GV(t) do { const int kt_ = ATT_KT(t); vreg = *(const u32x4*)(vt + (size_t)srow * KVLEN + kt_ * 64 + 8 * sch); } while (0)
#define ATT_QK(S0, S1, kb) do { const unsigned char* Kl_ = lds + (kb) * 9216; \
        _Pragma("unroll") for (int ks = 0; ks < 4; ++ks) { \
            const bf16x8 k0 = *(const bf16x8*)(Kl_ + r32 * 144 + (16 * ks + 8 * hi) * 2), k1 = *(const bf16x8*)(Kl_ + (32 + r32) * 144 + (16 * ks + 8 * hi) * 2); \
            if (ks == 0) { S0 = __builtin_amdgcn_mfma_f32_32x32x16_bf16(k0, qr[0], negm, 0, 0, 0); S1 = __builtin_amdgcn_mfma_f32_32x32x16_bf16(k1, qr[0], negm, 0, 0, 0); } \
            else { S0 = __builtin_amdgcn_mfma_f32_32x32x16_bf16(k0, qr[ks], S0, 0, 0, 0); S1 = __builtin_amdgcn_mfma_f32_32x32x16_bf16(k1, qr[ks], S1, 0, 0, 0); } } } while (0)
#define ATT_TILE(SC0, SC1, SN0, SN1, t) do { \
        if ((t) + 2 < NT) ATT_GK((t) + 2); \
        if ((t) + 1 < NT) { ATT_GV((t) + 1); ATT_QK(SN0, SN1, ((t) + 1) & 1); } \
        if (isB && (t) >= 4) { const int kp0 = (ATT_KT(t) - 4) * 64 - qpos; \
            _Pragma("unroll") for (int r = 0; r < 16; ++r) { const int d0 = kp0 + crow(r, hi); if (d0 > 128 || d0 < -128) SC0[r] = -1e30f; const int d1 = d0 + 32; if (d1 > 128 || d1 < -128) SC1[r] = -1e30f; } } \
        float mx = SC0[0]; \
        _Pragma("unroll") for (int r = 1; r < 16; ++r) mx = fmaxf(mx, SC0[r]); \
        _Pragma("unroll") for (int r = 0; r < 16; ++r) mx = fmaxf(mx, SC1[r]); \
        mx = fmaxf(mx, __shfl_xor(mx, 32)); \
        if (__any(mx > 8.f)) { const float dl = fmaxf(mx, 0.f); m_run += dl; const float alpha = __builtin_amdgcn_exp2f(-dl); l_run *= alpha; \
            _Pragma("unroll") for (int r = 0; r < 16; ++r) { o[0][r] *= alpha; o[1][r] *= alpha; SC0[r] -= dl; SC1[r] -= dl; negm[r] = -m_run; } \
            if ((t) + 1 < NT) { _Pragma("unroll") for (int r = 0; r < 16; ++r) { SN0[r] -= dl; SN1[r] -= dl; } } } \
        float psa = 0.f, psb = 0.f, psc = 0.f, psd = 0.f; \
        _Pragma("unroll") for (int r = 0; r < 16; r += 2) { SC0[r] = __builtin_amdgcn_exp2f(SC0[r]); SC1[r] = __builtin_amdgcn_exp2f(SC1[r]); SC0[r + 1] = __builtin_amdgcn_exp2f(SC0[r + 1]); SC1[r + 1] = __builtin_amdgcn_exp2f(SC1[r + 1]); \
            psa = fadd_s(psa, SC0[r]); psb = fadd_s(psb, SC1[r]); psc = fadd_s(psc, SC0[r + 1]); psd = fadd_s(psd, SC1[r + 1]); } \
        l_run += (psa + psb) + (psc + psd); \
        bf16x8 pk[2][2]; \
        _Pragma("unroll") for (int s_ = 0; s_ < 2; ++s_) { u32x4 w0, w1; \
            w0.x = cvt_pk(SC0[8 * s_ + 0], SC0[8 * s_ + 1]); w0.y = cvt_pk(SC0[8 * s_ + 2], SC0[8 * s_ + 3]); w0.z = cvt_pk(SC0[8 * s_ + 4], SC0[8 * s_ + 5]); w0.w = cvt_pk(SC0[8 * s_ + 6], SC0[8 * s_ + 7]); \
            w1.x = cvt_pk(SC1[8 * s_ + 0], SC1[8 * s_ + 1]); w1.y = cvt_pk(SC1[8 * s_ + 2], SC1[8 * s_ + 3]); w1.z = cvt_pk(SC1[8 * s_ + 4], SC1[8 * s_ + 5]); w1.w = cvt_pk(SC1[8 * s_ + 6], SC1[8 * s_ + 7]); \
            pk[0][s_] = __builtin_bit_cast(bf16x8, w0); pk[1][s_] = __builtin_bit_cast(bf16x8, w1); } \
        { const unsigned char* Vl_ = lds + 18432 + ((t) & 1) * 9216; \
          _Pragma("unroll") for (int dh = 0; dh < 2; ++dh) _Pragma("unroll") for (int kh = 0; kh < 2; ++kh) _Pragma("unroll") for (int s_ = 0; s_ < 2; ++s_) { \
              const unsigned char* vp = Vl_ + (32 * dh + r32) * 144 + (32 * kh + 16 * s_ + 4 * hi) * 2; \
              const u32x2 lo = *(const u32x2*)vp, hh = *(const u32x2*)(vp + 16); const u32x4 vv = {lo.x, lo.y, hh.x, hh.y}; \
              o[dh] = __builtin_amdgcn_mfma_f32_32x32x16_bf16(__builtin_bit_cast(bf16x8, vv), pk[kh][s_], o[dh], 0, 0, 0); } } \
        if ((t) + 2 < NT) *(u32x4*)(lds + ((t) & 1) * 9216 + soff) = kreg; \
        if ((t) + 1 < NT) *(u32x4*)(lds + 18432 + (((t) + 1) & 1) * 9216 + soff) = vreg; \
        __syncthreads(); } while (0)
    ATT_GK(0); ATT_GV(0); *(u32x4*)(lds + soff) = kreg; *(u32x4*)(lds + 18432 + soff) = vreg;
    ATT_GK(1); *(u32x4*)(lds + 9216 + soff) = kreg;
    __syncthreads();
    f32x16 sa0, sa1, sb0, sb1;
#pragma unroll
    for (int r = 0; r < 16; ++r) { sb0[r] = 0.f; sb1[r] = 0.f; }
    ATT_QK(sa0, sa1, 0);
    __syncthreads();
    for (int t = 0; t < NT; t += 2) {
        ATT_TILE(sa0, sa1, sb0, sb1, t);
        if (t + 1 < NT) ATT_TILE(sb0, sb1, sa0, sa1, t + 1);
    }
#undef ATT_KT
#undef ATT_GK
#undef ATT_GV
#undef ATT_QK
#undef ATT_TILE
    const float lt = l_run + __shfl_xor(l_run, 32); const float inv = 1.f / lt;
    bf16_t* fp = (bf16_t*)(a.ws + WS_FEAT) + (size_t)qrow * DM + (isB ? 256 : 0) + head * 64 + 4 * hi;
#pragma unroll
    for (int dh = 0; dh < 2; ++dh)
#pragma unroll
        for (int rq = 0; rq < 4; ++rq) { u32x2 w; w.x = cvt_pk(o[dh][4 * rq] * inv, o[dh][4 * rq + 1] * inv); w.y = cvt_pk(o[dh][4 * rq + 2] * inv, o[dh][4 * rq + 3] * inv);
            *(u32x2*)(fp + 32 * dh + 8 * rq) = w; }
}

__device__ __forceinline__ void phase_carry(const Args& a, int lane, int wave, int G) {
    if (wave != 0) return;
    const float* SUM = (const float*)(a.ws + WS_SUM); float* CARRY = (float*)(a.ws + WS_CARRY);
    for (int t = blockIdx.x * 64 + lane; t < NBATCH * 2 * 512; t += G * 64) {
        const int b = t >> 10, dir = (t >> 9) & 1, ch = t & 511;
        const float* S = SUM + (size_t)((b * NCHUNK) * 2 + dir) * 2 * 512 + ch;
        float A[NCHUNK], Hh[NCHUNK];
#pragma unroll
        for (int j = 0; j < NCHUNK; ++j) { A[j] = S[(size_t)j * 2048]; Hh[j] = S[(size_t)j * 2048 + 512]; }
        float* C = CARRY + (size_t)(b * NCHUNK * 2 + dir) * 512 + ch;
        float h = 0.f;
        if (dir == 0) {
#pragma unroll
            for (int i = 0; i < NCHUNK; ++i) { C[(size_t)i * 1024] = h; h = A[i] * h + Hh[i]; }
        } else {
#pragma unroll
            for (int i = 0; i < NCHUNK; ++i) { const int c = i < 4 ? 3 - i : NCHUNK + 3 - i; C[(size_t)c * 1024] = h; h = A[c] * h + Hh[c]; }
        }
    }
}

__device__ __forceinline__ void phase_mix(const Args& a, int l, unsigned char* lds, int tid, int lane, int wave, int G) {
    const int NA = NBATCH * 2 * 16, NC = l == 0 ? NBATCH * 2 * 2 : 0;
    const int total = 2 * NA + 2 * NC;
#ifdef PROBE_ATT2
    for (int rep = 0; rep < 2; ++rep)
#endif
    for (int u = blockIdx.x; u < total; u += G) {
        int type, r = u;
        if (r < NA) type = 0; else if (r < 2 * NA) { type = 1; r -= NA; } else if (r < 2 * NA + NC) { type = 2; r -= 2 * NA; } else { type = 3; r -= 2 * NA + NC; }
        int b, kvh, qt;
        if (type < 2) { b = r >> 5; kvh = (r >> 4) & 1; qt = r & 15; } else { b = r >> 2; kvh = (r >> 1) & 1; qt = r & 1; }
#ifndef NO_ATT
        attn_unit(a, l, type, b, kvh, qt, lds, tid, lane, wave);
#endif
    }
    __syncthreads();
    const int gw = blockIdx.x * 8 + wave, NGW = G * 8;
#ifdef PROBE_LRU2
    for (int rep = 0; rep < 2; ++rep)
#endif
    for (int it = gw; it < NBATCH * NCHUNK * 8; it += NGW) {
        const int c = (it % (NCHUNK * 8)) >> 3;
        if (l == NLAYER - 1 && c < 4) continue;
#ifndef NO_LRUF
        lru_final_item(a, l, it, lane, (float*)(lds + wave * 16384));
#endif
    }
}

#define XB_TMO      128
#define XB_XCNT(j)  (256  + 64 * (j))
#define XB_XSUB(j)  (1280 + 64 * (j))
#define XB_XGEN(j)  (2304 + 64 * (j))
#define XB_TOP      3328
#define XB_TOPGEN   3392
#define XCD_BAR_WORDS 3456
#define XB_SPIN_CAP (1u << 18)

__device__ __forceinline__ unsigned xb_ld(unsigned* p)              { return __hip_atomic_load(p, __ATOMIC_RELAXED, __HIP_MEMORY_SCOPE_AGENT); }
__device__ __forceinline__ unsigned xb_add(unsigned* p, unsigned v) { return __hip_atomic_fetch_add(p, v, __ATOMIC_RELAXED, __HIP_MEMORY_SCOPE_AGENT); }
__device__ __forceinline__ unsigned xb_xcc_id() { return (unsigned)__builtin_amdgcn_s_getreg((3 << 11) | 20) & 0xFu; }
#define XB_SPIN(cond, bar) do { unsigned _sp = 0; while (cond) { __builtin_amdgcn_s_sleep(1); \
    if ((++_sp & 255u) == 0u) { if (xb_ld(&(bar)[XB_TMO])) break; if (_sp > XB_SPIN_CAP) { atomicAdd(&(bar)[XB_TMO], 1u); break; } } } } while (0)

struct XcdBarrier {
    unsigned* bar; unsigned x;
    volatile LAS unsigned* st;
};

__device__ __forceinline__ XcdBarrier xcd_barrier_post(unsigned* bar, volatile LAS unsigned* st) {
    XcdBarrier b; b.bar = bar; b.x = xb_xcc_id(); b.st = st;
    if (threadIdx.x == 0) (void)xb_add(&bar[XB_XCNT(b.x)], 1u);
    return b;
}
__device__ __forceinline__ void xcd_barrier_complete(unsigned* bar, unsigned x, unsigned& nloc, unsigned& nx) {
    const unsigned G = gridDim.x * gridDim.y * gridDim.z;
    unsigned sum, cnt, mine, sp = 0u;
    for (;;) {
        sum = 0u; cnt = 0u; mine = 0u;
        unsigned cv[16];
#pragma unroll
        for (unsigned j = 0; j < 16; ++j) cv[j] = xb_ld(&bar[XB_XCNT(j)]);
#pragma unroll
        for (unsigned j = 0; j < 16; ++j) { const unsigned c = cv[j]; sum += c; cnt += (c > 0u) ? 1u : 0u; mine = (j == x) ? c : mine; }
        if (sum == G) break;
        __builtin_amdgcn_s_sleep(1);
        if ((++sp & 255u) == 0u) { if (xb_ld(&bar[XB_TMO])) break; if (sp > XB_SPIN_CAP) { atomicAdd(&bar[XB_TMO], 1u); break; } }
    }
    nloc = mine > 0u ? mine : 1u; nx = cnt > 0u ? cnt : 1u;
}

__device__ __forceinline__ void xcd_barrier(const XcdBarrier& b) {
    asm volatile("s_waitcnt vmcnt(0)" ::: "memory");
    __syncthreads();
    if (threadIdx.x == 0) {
        unsigned* bar = b.bar;
        __builtin_amdgcn_s_waitcnt(0);
        unsigned nloc = b.st[0], nx = b.st[1];
        if (nloc == 0u) { xcd_barrier_complete(bar, b.x, nloc, nx); b.st[0] = nloc; b.st[1] = nx; }
        const unsigned old = xb_add(&bar[XB_XSUB(b.x)], 1u);
        const unsigned gen = old / nloc;
        if (old + 1u == (gen + 1u) * nloc) {
            __builtin_amdgcn_fence(__ATOMIC_RELEASE, "agent");
            asm volatile("s_waitcnt vmcnt(0)" ::: "memory");
            const unsigned og = xb_add(&bar[XB_TOP], 1u);
            const unsigned tg = og / nx;
            if (og + 1u == (tg + 1u) * nx) xb_add(&bar[XB_TOPGEN], 1u);
            else XB_SPIN(xb_ld(&bar[XB_TOPGEN]) == tg, bar);
            __builtin_amdgcn_fence(__ATOMIC_ACQUIRE, "agent");
            xb_add(&bar[XB_XGEN(b.x)], 1u);
            asm volatile("s_waitcnt vmcnt(0)" ::: "memory");
        } else {
            XB_SPIN(xb_ld(&bar[XB_XGEN(b.x)]) == gen, bar);
            __builtin_amdgcn_fence(__ATOMIC_ACQUIRE, "agent");
            asm volatile("s_waitcnt vmcnt(0)" ::: "memory");
        }
    }
    __syncthreads();
}


__global__ void __launch_bounds__(512, 2) fwd_kernel(Args a) {
    extern __shared__ __attribute__((aligned(16))) unsigned char lds[];
    cg::grid_group grid = cg::this_grid();
    if (threadIdx.x < 64) ((LAS unsigned*)((LAS unsigned char*)lds + MISC_OFF))[threadIdx.x] = 0u;
    __syncthreads();
    XcdBarrier bar = xcd_barrier_post((unsigned*)(a.ws + WS_CTL) + CW_BAR, (volatile LAS unsigned*)((LAS unsigned char*)lds + MISC_OFF) + 8);
    const int G = gridDim.x, NGW = G * 8;
    const float* MOD = (const float*)(a.ws + WS_MOD);
    bf16_t* H = (bf16_t*)(a.ws + WS_H); bf16_t* Zb = (bf16_t*)(a.ws + WS_Z); bf16_t* FEAT = (bf16_t*)(a.ws + WS_FEAT); bf16_t* Y = (bf16_t*)(a.ws + WS_Y); bf16_t* HID = (bf16_t*)(a.ws + WS_HID);
    float* XC = (float*)(a.ws + WS_XC); bf16_t* SLAB = (bf16_t*)(a.ws + WS_SLAB);
    for (int ph = a.ph_lo; ph < a.ph_hi; ++ph) {
        if (ph > a.ph_lo) { if (a.ws == nullptr) grid.sync(); xcd_barrier(bar); }
        int tid = threadIdx.x; asm volatile("" : "+v"(tid)); const int lane = tid & 63, wave = __builtin_amdgcn_readfirstlane(tid >> 6); const int gw = blockIdx.x * 8 + wave;
        if (ph == 0) {
#ifndef NO_PRO
 prologue_a(a, lds, tid, lane, wave, G);
#endif
 continue; }
        if (ph == 1) {
            phase_rows(a, 0, 0, MT, lane, gw, NGW);
            continue;
        }
        const int l = (ph - 2) / PH_PER_LAYER, k9 = (ph - 2) % PH_PER_LAYER;
        if (k9 == 2) { phase_carry(a, lane, wave, G); continue; }
        const int k = k9 < 2 ? k9 : k9 - 1;
        const int Mrows = (l == NLAYER - 1) ? ML : MT;
#ifndef NO_GEMM
        if (k == 0 || k == 3 || k == 6) {
            const int nparts = (l == 0 && k != 0) ? 2 : 1;
            for (int part = 0; part < nparts; ++part) {
                pg8::Gemm g; bf16_t* O; int ldc; int SK = 1; size_t slab = 0;
                if (k == 0) { g = pg8::Gemm{H, (const bf16_t*)(a.ws + WS_WIN) + (size_t)l * INW * DM, MT, INW, DM, DM}; O = Zb; ldc = INW; }
                else if (k == 3) { const bf16_t* W = (const bf16_t*)(a.ws + WS_WOUT) + (size_t)l * DM * DM; ldc = DM;
                    if (part == 0) { g = pg8::Gemm{FEAT, W, ML, DM, DM, DM}; O = Y; } else { g = pg8::Gemm{FEAT + (size_t)ML * DM, W, MC, DM, DM / 4, DM}; O = SLAB; SK = 4; slab = (size_t)MC * DM; } }
                else { const bf16_t* W = (const bf16_t*)(a.ws + WS_W2) + (size_t)l * DM * DFF; ldc = DM;
                    if (part == 0) { g = pg8::Gemm{HID, W, ML, DM, DFF, DFF}; O = H; } else { g = pg8::Gemm{HID + (size_t)ML * DFF, W, MC, DM, DFF / 4, DFF}; O = SLAB; SK = 4; slab = (size_t)MC * DM; } }
                pg8::StaticOrder S; S.init(g.M, g.N, G, (int)blockIdx.x, SK);
                pg8::EpiStore<0> E{O, ldc, slab};
                pg8::gemm_phase<pg8::EpiStore<0>, pg8::StaticOrder, true, true>((LAS unsigned char*)lds, g, S, E);
            }
        } else if (k == 5) {
            pg8::Gemm g{H, (const bf16_t*)(a.ws + WS_W1) + (size_t)l * DFF * DM, Mrows, DFF, DM, DM};
            pg8::StaticOrder S; S.init(g.M, g.N, G, (int)blockIdx.x, 1);
            pg8::EpiStore<2> E{HID, DFF, 0};
            pg8::gemm_phase<pg8::EpiStore<2>, pg8::StaticOrder, true, true>((LAS unsigned char*)lds, g, S, E);
        } else
#endif
        if (k == 1) {
#ifndef NO_PREP
 phase_prep(a, l, lds, lane, wave, G);
#endif

        } else if (k == 2) {
#ifndef NO_MIX
 phase_mix(a, l, lds, tid, lane, wave, G);
#endif

        } else {
            phase_rows(a, k == 4 ? 1 : 2, l, Mrows, lane, gw, NGW);
        }
    }
#ifdef DBG_STOP
    grid.sync();
    { const int tid = threadIdx.x; const size_t gt = (size_t)blockIdx.x * 512 + tid, NT_ = (size_t)G * 512;
      for (size_t i = gt; i < (size_t)ML * DM; i += NT_) { const size_t m = i >> 10, c = i & 1023; float v = 0.f;
#if DBG_SRC == 0
          v = bf_lo(H[m * DM + c]) + (m < MC ? bf_lo(H[(ML + m) * DM + c]) : 0.f);
#elif DBG_SRC == 1
          v = bf_lo(Zb[m * INW + c]) + bf_lo(Zb[m * INW + 1024 + c]) + (m < MC ? bf_lo(Zb[(ML + m) * INW + c]) + bf_lo(Zb[(ML + m) * INW + 1024 + c]) : 0.f);
#elif DBG_SRC == 2
          v = bf_lo(FEAT[m * DM + c]) + (m < MC ? bf_lo(FEAT[(ML + m) * DM + c]) : 0.f);
#elif DBG_SRC == 3
          { const bf16_t* VT = (const bf16_t*)(a.ws + WS_VT); const float* SUM = (const float*)(a.ws + WS_SUM); v = (i < (size_t)NBATCH * 4 * 64 * KVLEN ? bf_lo(VT[i]) : 0.f) + (i < (size_t)NBATCH * NCHUNK * 2 * 2 * 512 ? SUM[i] : 0.f); }
#elif DBG_SRC == 5
          v = bf_lo(Zb[m * INW + c]) + bf_lo(Zb[m * INW + 1024 + c]) + (m < MC ? bf_lo(Zb[(ML + m) * INW + c]) + bf_lo(Zb[(ML + m) * INW + 1024 + c]) : 0.f);
          { const bf16_t* VT = (const bf16_t*)(a.ws + WS_VT); const float* SUM = (const float*)(a.ws + WS_SUM); v += (i < (size_t)NBATCH * 4 * 64 * KVLEN ? bf_lo(VT[i]) : 0.f) + (i < (size_t)NBATCH * NCHUNK * 2 * 2 * 512 ? SUM[i] : 0.f); }
#elif DBG_SRC == 6
          { const float* SUM = (const float*)(a.ws + WS_SUM); v = (i < (size_t)NBATCH * NCHUNK * 2 * 2 * 512 ? SUM[i] : 0.f); }
#elif DBG_SRC == 7
          { const bf16_t* VT = (const bf16_t*)(a.ws + WS_VT); v = (i < (size_t)NBATCH * 4 * 64 * KVLEN ? bf_lo(VT[i]) : 0.f); }
#elif DBG_SRC == 8
          { const float* SUM = (const float*)(a.ws + WS_SUM); v = (i < (size_t)NBATCH * NCHUNK * 2 * 2 * 512 ? SUM[i] : 0.f); if (!(fabsf(v) < 1e30f)) v = 12345.f; }
#elif DBG_SRC == 9
          { const bf16_t* LW = (const bf16_t*)(a.ws + WS_LRUW); const float* RP = (const float*)(a.ws + WS_ROPE);
            v = (i < 262144 ? bf_lo(LW[i]) : 0.f) + (i < 208896 ? MOD[i] : 0.f) + (i < 3072 ? RP[i] : 0.f); }
#elif DBG_SRC == 4
          v = bf_lo(Y[m * DM + c]) + (m < MC ? bf_lo(Y[(ML + m) * DM + c]) : 0.f);
#endif
          a.out[i] = v; } }
#endif
}

extern "C" void kernel_launch(void* const* d_in, const int* in_sizes, int n_in, void* d_out, int out_size, void* d_ws, size_t ws_size, hipStream_t stream) {
    static int grid = 0;
    if (grid == 0) {
        if (n_in != N_IN || ws_size < WS_END) { fprintf(stderr, "kernel_launch: unexpected n_in %d or ws_size %zu\n", n_in, ws_size); grid = -1; return; }
        int dev = 0, cus = 0, per_cu = 0;
        hipGetDevice(&dev); hipDeviceGetAttribute(&cus, hipDeviceAttributeMultiprocessorCount, dev);
        hipFuncSetAttribute((const void*)fwd_kernel, hipFuncAttributeMaxDynamicSharedMemorySize, LDS_BYTES);
        if (hipOccupancyMaxActiveBlocksPerMultiprocessor(&per_cu, (const void*)fwd_kernel, 512, LDS_BYTES) != hipSuccess || per_cu < 1) per_cu = 1;
        (void)hipGetLastError();
        grid = cus * 1;
        if (grid <= 0) grid = 256;
    }
    if (grid < 0) return;
    if (hipMemsetAsync((char*)d_ws + WS_CTL, 0, CTL_ZERO_BYTES, stream) != hipSuccess) { fprintf(stderr, "kernel_launch: memset failed\n"); return; }
    Args a{};
    for (int i = 0; i < N_IN; ++i) a.in[i] = (const float*)d_in[i];
    a.out = (float*)d_out; a.ws = (unsigned char*)d_ws;
#if MK_MULTI
    for (int ph = 0; ph < NPHASE; ++ph) { a.ph_lo = ph; a.ph_hi = ph + 1; hipLaunchKernelGGL(fwd_kernel, dim3(grid), dim3(512), LDS_BYTES, stream, a); }
#else
#ifdef DBG_STOP
    a.ph_lo = 0; a.ph_hi = DBG_STOP;
#else
    a.ph_lo = 0; a.ph_hi = NPHASE;
#endif
    void* args[] = {&a};
    hipError_t e = hipLaunchCooperativeKernel((const void*)fwd_kernel, dim3(grid), dim3(512), args, LDS_BYTES, stream);
    if (e != hipSuccess) fprintf(stderr, "cooperative launch failed: %s (grid %d)\n", hipGetErrorString(e), grid);
#endif
}
```
